# Optimizing an MI355X kernel written in HIP

```python
import jax, jax.numpy as jnp
from jax import lax
import numpy as np

D_MODEL = 2048
BATCH = 16
SEQ = 256
DEPTH = 4
DEC_BATCH = 8
DEC_SEQ = 4096
PAST_LEN = 512

GRID_W = 64
N_MLA_LAYERS = (DEPTH + 1) // 2
N_SG_LAYERS = DEPTH // 2
EPS = 1e-6
CONV_WIDTH = 2048
MLA_HEADS = 16
QK_NOPE = 128
QK_ROPE = 64
V_HEAD = 128
Q_LORA = 512
KV_LORA = 512
ROPE_BASE = 10000.0
Q_BLOCK = 128
MLA_WIDTH = MLA_HEADS * V_HEAD
CHUNK = 128
SG_WIDTH = 4096
SG_GROUPS = 16
EVEN_IN = 4 * CONV_WIDTH + Q_LORA + KV_LORA + QK_ROPE + MLA_WIDTH
EVEN_SPLITS = (CONV_WIDTH, 2 * CONV_WIDTH, 3 * CONV_WIDTH, 4 * CONV_WIDTH,
               4 * CONV_WIDTH + Q_LORA, 4 * CONV_WIDTH + Q_LORA + KV_LORA,
               4 * CONV_WIDTH + Q_LORA + KV_LORA + QK_ROPE)
EVEN_MIX = CONV_WIDTH + MLA_WIDTH
ODD_IN = 3 * SG_WIDTH

kernel_name = 'hybrid_diffusion_conv_mla_sgmlp_step'

F32 = jnp.float32


def rmsnorm(x, g):
    x32 = x.astype(F32)
    y = x32 * lax.rsqrt(jnp.mean(x32 * x32, axis=-1, keepdims=True) + EPS) * g.astype(F32)
    return y.astype(x.dtype)


def layernorm(x, g, b):
    x32 = x.astype(F32)
    mu = jnp.mean(x32, axis=-1, keepdims=True)
    xc = x32 - mu
    var = jnp.mean(xc * xc, axis=-1, keepdims=True)
    return (xc * lax.rsqrt(var + EPS) * g.astype(F32) + b.astype(F32)).astype(x.dtype)


def ada_mod(cond, w, b):
    m = jax.nn.silu(cond) @ w + b
    return jnp.split(m[:, None, :], 3, axis=-1)


def dwconv3(x, w):
    xp = jnp.pad(x, ((0, 0), (1, 1), (0, 0)))
    return xp[:, :-2] * w[0] + xp[:, 1:-1] * w[1] + xp[:, 2:] * w[2]


def axial_rope_tables(n):
    rows = n // GRID_W
    row = jnp.repeat(jnp.arange(rows, dtype=F32), GRID_W)
    col = jnp.tile(jnp.arange(GRID_W, dtype=F32), rows)
    n_freq = QK_ROPE // 4
    inv = ROPE_BASE ** (-jnp.arange(n_freq, dtype=F32) / n_freq)
    ar = row[:, None] * inv
    ac = col[:, None] * inv
    ang = jnp.concatenate([ar, ar, ac, ac], axis=-1)
    return jnp.cos(ang), jnp.sin(ang)


def apply_rope(x, cos, sin):
    xr = x.reshape(x.shape[:-1] + (2, 2, QK_ROPE // 4))
    rot = jnp.stack([-xr[..., 1, :], xr[..., 0, :]], axis=-2).reshape(x.shape)
    return (x.astype(F32) * cos + rot.astype(F32) * sin).astype(x.dtype)


def mla_attend(q_nope, q_pe, k_nope, k_pe, v):
    bsz, n, h, _ = q_nope.shape
    nb = n // Q_BLOCK
    qn = q_nope.reshape(bsz, nb, Q_BLOCK, h, QK_NOPE).transpose(1, 0, 2, 3, 4)
    qp = q_pe.reshape(bsz, nb, Q_BLOCK, h, QK_ROPE).transpose(1, 0, 2, 3, 4)
    scale = (QK_NOPE + QK_ROPE) ** -0.5

    def block(args):
        qn_b, qp_b = args
        s = (jnp.einsum('bqhd,bkhd->bhqk', qn_b, k_nope, preferred_element_type=F32)
             + jnp.einsum('bqhr,bkr->bhqk', qp_b, k_pe, preferred_element_type=F32))
        p = jax.nn.softmax(s * scale, axis=-1)
        return jnp.einsum('bhqk,bkhd->bqhd', p.astype(v.dtype), v)

    o = lax.map(block, (qn, qp))
    return o.transpose(1, 0, 2, 3, 4).reshape(bsz, n, h * V_HEAD)


def even_mixer(h, w_in, conv_w, q_norm_g, w_qb, kv_norm_g, w_kvb, w_out, rope, ctx):
    bsz, n, _ = h.shape
    cb, cc, cx, cg, q_a, ckv_raw, kpe, mg = jnp.split(h @ w_in, EVEN_SPLITS, axis=-1)
    y_conv = cb * dwconv3(cc * cx, conv_w) * jax.nn.silu(cg)
    q = (rmsnorm(q_a, q_norm_g) @ w_qb).reshape(bsz, n, MLA_HEADS, QK_NOPE + QK_ROPE)
    q_nope, q_pe = q[..., :QK_NOPE], q[..., QK_NOPE:]
    ckv = rmsnorm(ckv_raw, kv_norm_g)
    if rope is None:
        kpe_keys = kpe
    else:
        cos, sin = rope
        q_pe = apply_rope(q_pe, cos[:, None, :], sin[:, None, :])
        kpe_keys = apply_rope(kpe, cos, sin)
    if ctx is None:
        ckv_all, kpe_all = ckv, kpe_keys
    else:
        ckv_all = jnp.concatenate([ctx[0], ckv], axis=1)
        kpe_all = jnp.concatenate([ctx[1], kpe_keys], axis=1)
    kv = (ckv_all @ w_kvb).reshape(bsz, ckv_all.shape[1], MLA_HEADS, QK_NOPE + V_HEAD)
    k_nope, v = kv[..., :QK_NOPE], kv[..., QK_NOPE:]
    y_att = mla_attend(q_nope, q_pe, k_nope, kpe_all, v) * jax.nn.silu(mg)
    out = jnp.concatenate([y_conv, y_att], axis=-1) @ w_out
    return out, ckv, kpe


def odd_mixer(h, w_in, ln_g, ln_b, w_s, b_s, w_out):
    bsz, n, _ = h.shape
    u, v, g = jnp.split(h @ w_in, 3, axis=-1)
    v = layernorm(v, ln_g, ln_b)
    vc = v.reshape(bsz, n // CHUNK, CHUNK, SG_GROUPS, SG_WIDTH // SG_GROUPS)
    vs = jnp.einsum('gpq,bcqgd->bcpgd', w_s, vc) + b_s.T[:, :, None]
    y = u * vs.reshape(bsz, n, SG_WIDTH) * jax.nn.silu(g)
    return y @ w_out


def trunk(x, cond, rope, cache_ckv, cache_kpe, norm_g, w_ada, b_ada,
          e_w_in, e_conv_w, e_q_norm_g, e_w_qb, e_kv_norm_g, e_w_kvb, e_w_out,
          o_w_in, o_ln_g, o_ln_b, o_w_s, o_b_s, o_w_out, final_g):
    ckvs, kpes = [], []
    for l in range(DEPTH):
        shift, scale, gate = ada_mod(cond, w_ada[l], b_ada[l])
        h = rmsnorm(x, norm_g[l]) * (1 + scale) + shift
        i = l // 2
        if l % 2 == 0:
            ctx = None if cache_ckv is None else (cache_ckv[:, i], cache_kpe[:, i])
            out, ckv, kpe = even_mixer(h, e_w_in[i], e_conv_w[i], e_q_norm_g[i], e_w_qb[i],
                                       e_kv_norm_g[i], e_w_kvb[i], e_w_out[i], rope, ctx)
            ckvs.append(ckv)
            kpes.append(kpe)
        else:
            out = odd_mixer(h, o_w_in[i], o_ln_g[i], o_ln_b[i], o_w_s[i], o_b_s[i], o_w_out[i])
        x = x + gate * out
    return rmsnorm(x, final_g), ckvs, kpes


def setup_inputs(seed: int = 0) -> dict:
    key = jax.random.key(seed)
    ks = jax.random.split(key, 24)
    nrm = jax.random.normal
    D = D_MODEL
    return {
        'x_prompt': nrm(ks[0], (BATCH, SEQ, D), F32),
        'x_sample': nrm(ks[1], (DEC_BATCH, DEC_SEQ, D), F32),
        'cache_ckv': nrm(ks[2], (DEC_BATCH, N_MLA_LAYERS, PAST_LEN, KV_LORA), F32),
        'cache_kpe': nrm(ks[3], (DEC_BATCH, N_MLA_LAYERS, PAST_LEN, QK_ROPE), F32),
        'c': nrm(ks[4], (DEC_BATCH, D), F32),
        'c_ctx': nrm(ks[5], (D,), F32),
        'norm_g': 1.0 + 0.02 * nrm(ks[6], (DEPTH, D), F32),
        'w_ada': nrm(ks[7], (DEPTH, D, 3 * D), F32) * D ** -0.5,
        'b_ada': 0.02 * nrm(ks[8], (DEPTH, 3 * D), F32),
        'e_w_in': nrm(ks[9], (N_MLA_LAYERS, D, EVEN_IN), F32) * D ** -0.5,
        'e_conv_w': nrm(ks[10], (N_MLA_LAYERS, 3, CONV_WIDTH), F32) * 3 ** -0.5,
        'e_q_norm_g': 1.0 + 0.02 * nrm(ks[11], (N_MLA_LAYERS, Q_LORA), F32),
        'e_w_qb': nrm(ks[12], (N_MLA_LAYERS, Q_LORA, MLA_HEADS * (QK_NOPE + QK_ROPE)), F32) * Q_LORA ** -0.5,
        'e_kv_norm_g': 1.0 + 0.02 * nrm(ks[13], (N_MLA_LAYERS, KV_LORA), F32),
        'e_w_kvb': nrm(ks[14], (N_MLA_LAYERS, KV_LORA, MLA_HEADS * (QK_NOPE + V_HEAD)), F32) * KV_LORA ** -0.5,
        'e_w_out': nrm(ks[15], (N_MLA_LAYERS, EVEN_MIX, D), F32) * EVEN_MIX ** -0.5,
        'o_w_in': nrm(ks[16], (N_SG_LAYERS, D, ODD_IN), F32) * D ** -0.5,
        'o_ln_g': 1.0 + 0.02 * nrm(ks[17], (N_SG_LAYERS, SG_WIDTH), F32),
        'o_ln_b': 0.02 * nrm(ks[18], (N_SG_LAYERS, SG_WIDTH), F32),
        'o_w_s': nrm(ks[19], (N_SG_LAYERS, SG_GROUPS, CHUNK, CHUNK), F32) * CHUNK ** -0.5,
        'o_b_s': 1.0 + 0.1 * nrm(ks[20], (N_SG_LAYERS, SG_GROUPS, CHUNK), F32),
        'o_w_out': nrm(ks[21], (N_SG_LAYERS, SG_WIDTH, D), F32) * SG_WIDTH ** -0.5,
        'final_g': 1.0 + 0.02 * nrm(ks[22], (D,), F32),
    }


def reference(x_prompt, x_sample, cache_ckv, cache_kpe, c, c_ctx, norm_g, w_ada, b_ada,
              e_w_in, e_conv_w, e_q_norm_g, e_w_qb, e_kv_norm_g, e_w_kvb, e_w_out,
              o_w_in, o_ln_g, o_ln_b, o_w_s, o_b_s, o_w_out, final_g):
    y_prompt, ckvs, kpes = trunk(x_prompt, c_ctx[None, :], None, None, None, norm_g, w_ada, b_ada,
                                 e_w_in, e_conv_w, e_q_norm_g, e_w_qb, e_kv_norm_g, e_w_kvb, e_w_out,
                                 o_w_in, o_ln_g, o_ln_b, o_w_s, o_b_s, o_w_out, final_g)
    new_ckv = jnp.stack(ckvs, axis=1)
    new_kpe = jnp.stack(kpes, axis=1)
    rope = axial_rope_tables(x_sample.shape[1])
    y_sample, _, _ = trunk(x_sample, c, rope, cache_ckv, cache_kpe, norm_g, w_ada, b_ada,
                           e_w_in, e_conv_w, e_q_norm_g, e_w_qb, e_kv_norm_g, e_w_kvb, e_w_out,
                           o_w_in, o_ln_g, o_ln_b, o_w_s, o_b_s, o_w_out, final_g)
    return (y_prompt, y_sample, new_ckv, new_kpe)
```

```cpp
#include <hip/hip_runtime.h>
#include <cstdio>
#include <cstdint>
namespace pg8 {
#define PG8_LAS __attribute__((address_space(3)))
typedef unsigned short bf16_t;
typedef short bf16x8 __attribute__((ext_vector_type(8)));
typedef float f32x4 __attribute__((ext_vector_type(4)));
typedef unsigned u32x4 __attribute__((ext_vector_type(4)));
constexpr int BM = 256, BK = 64, HALF = 128, HTB = HALF * BK * 2  , STAGE_BYTES = 8 * HTB, NXCD = 8, WGM = 8;

__host__ __device__ __forceinline__ int lds_byte(int r, int c) { const int st = (r >> 4) * 2 + (c >> 5), rr = r & 15, cc = c & 31, ob = rr * 64 + cc * 2; return st * 1024 + (ob ^ (((ob >> 9) & 1) << 5)); }
__host__ __device__ __forceinline__ void stage_rc(int b, int& R, int& C) { const int st = b / 1024, sb = b % 1024, swz = sb ^ (((sb >> 9) & 1) << 5); R = (st >> 1) * 16 + swz / 64; C = (st & 1) * 32 + (swz % 64) / 2; }
__host__ __device__ __forceinline__ int perm32(int rho) { const int n = rho >> 4, i = rho & 15; return 8 * (i >> 2) + 4 * n + (i & 3); }

struct Unit { int pm, pn; };
struct Gemm { const bf16_t* A; const bf16_t* Bt; int M, N, K; };

struct StaticOrder {
    int nM, nN, nwg, G, c; unsigned q8, r8, nig, mnig;
    __host__ __device__ void init(int M, int N, int G_, int c_) { nM = M / BM; nN = N / BM; nwg = nM * nN; G = G_; c = c_; q8 = (unsigned)nwg / NXCD; r8 = (unsigned)nwg % NXCD; nig = (unsigned)(WGM * nN);
        mnig = (unsigned)((0x100000000ull + nig - 1) / nig); }
    __host__ __device__ bool next(int i, Unit& u) const {
        const unsigned L = (unsigned)i * (unsigned)G + (unsigned)c; if (L >= (unsigned)nwg) return false;
        const unsigned xcd = L & 7u, off = L >> 3; const unsigned wgid = (xcd < r8 ? xcd * (q8 + 1u) : r8 * (q8 + 1u) + (xcd - r8) * q8) + off;
        const unsigned gid = (unsigned)(((unsigned long long)wgid * mnig) >> 32), rem = wgid - gid * nig;
        u.pm = (int)(gid * WGM + (rem & (WGM - 1))); u.pn = (int)(rem / WGM); return true;
    }
    __device__ __forceinline__ void a_ready(const Unit&) const {}
    __device__ __forceinline__ void done(const Unit&) const {}
};
__device__ __forceinline__ unsigned cvt_pk_bf16(float lo, float hi) { unsigned r; asm volatile("v_cvt_pk_bf16_f32 %0, %1, %2" : "=v"(r) : "v"(lo), "v"(hi)); return r; }
typedef float f32x2 __attribute__((ext_vector_type(2)));
template <class Epi, class Sched, bool ALIGN_EPI = false, bool SP2 = false>
__device__ __forceinline__ void gemm_phase(PG8_LAS unsigned char* lds, const Gemm g, const Sched& S, const Epi& E) {
    int tid_ = threadIdx.x; asm volatile("" : "+v"(tid_));
    const int tid = tid_, wid = __builtin_amdgcn_readfirstlane(tid >> 6), lane = tid & 63, wr = wid >> 2, wc = wid & 3, fr = lane & 15, fq = lane >> 4;
    const int K = g.K, nt = K / BK;
    unsigned voffA[2], voffB[2];
#pragma unroll
    for (int i = 0; i < 2; ++i) { int R, C; stage_rc(tid * 16 + i * 8192, R, C); const int Rb = Epi::PERM ? ((R & ~31) + perm32(R & 31)) : R;
        voffA[i] = (unsigned)(R * K + C) * 2u; voffB[i] = (unsigned)(Rb * K + C) * 2u; }
    const size_t kstep = (size_t)(BK * 2);
    const size_t hstep = (size_t)HALF * K * 2;
    const size_t tstep = 2 * hstep;
    const unsigned ldsw = (unsigned)wid * 1024u;
    const int aoff = lds_byte(wr * 64 + fr, fq * 8), boff = lds_byte(wc * 32 + fr, fq * 8);
#define PG8_SA(b, h) (((b) * 2 + (h)) * HTB)
#define PG8_SB(b, h) ((4 + (b) * 2 + (h)) * HTB)
#define PG8_STAGE(bufoff, gbase, voff) do { _Pragma("unroll") for (int _i = 0; _i < 2; ++_i) \
        __builtin_amdgcn_global_load_lds((const unsigned*)((const char*)(gbase) + (voff)[_i]), (PG8_LAS unsigned*)(lds + (bufoff) + ldsw + _i * 8192), 16, 0, 0); } while (0)
#define PG8_LDA(dst, b, h) do { _Pragma("unroll") for (int m = 0; m < 4; ++m) _Pragma("unroll") for (int k = 0; k < 2; ++k) dst[m][k] = *(const PG8_LAS bf16x8*)(lds + PG8_SA(b, h) + aoff + m * 2048 + k * 1024); } while (0)
#define PG8_LDB(dst, b, h) do { _Pragma("unroll") for (int n = 0; n < 2; ++n) _Pragma("unroll") for (int k = 0; k < 2; ++k) dst[n][k] = *(const PG8_LAS bf16x8*)(lds + PG8_SB(b, h) + boff + n * 2048 + k * 1024); } while (0)
#define PG8_MMA(ai, bj, At, Bt) do { __builtin_amdgcn_s_setprio(1); _Pragma("unroll") for (int m = 0; m < 4; ++m) _Pragma("unroll") for (int n = 0; n < 2; ++n) _Pragma("unroll") for (int k = 0; k < 2; ++k) \
        acc[ai][bj][m][n] = __builtin_amdgcn_mfma_f32_16x16x32_bf16(Bt[n][k], At[m][k], acc[ai][bj][m][n], 0, 0, 0); __builtin_amdgcn_s_setprio(0); } while (0)
#define PG8_WAIT_V(n) asm volatile("s_waitcnt vmcnt(" #n ")" ::: "memory")
#define PG8_WAIT_L(n) asm volatile("s_waitcnt lgkmcnt(" #n ")" ::: "memory")
#define PG8_BAR __builtin_amdgcn_s_barrier()
#define PG8_SCHED __builtin_amdgcn_sched_barrier(0)
    Unit cur, nxt; int ui = 0;
    if (!S.next(0, cur)) return;
    f32x4 acc[2][2][4][2];
#pragma unroll
    for (int a = 0; a < 2; ++a)
#pragma unroll
        for (int b = 0; b < 2; ++b)
#pragma unroll
            for (int m = 0; m < 4; ++m)
#pragma unroll
                for (int n = 0; n < 2; ++n) acc[a][b][m][n] = (f32x4){0.f, 0.f, 0.f, 0.f};
    bf16x8 At[4][2], B0[2][2], B1[2][2];
    const char* cA = (const char*)g.A + (size_t)cur.pm * tstep; const char* cB = (const char*)g.Bt + (size_t)cur.pn * tstep;
    S.a_ready(cur);
    if constexpr (SP2) {
        PG8_STAGE(PG8_SB(0, 0), cB, voffB); PG8_STAGE(PG8_SB(0, 1), cB + hstep, voffB); PG8_STAGE(PG8_SA(0, 0), cA, voffA); PG8_STAGE(PG8_SA(0, 1), cA + hstep, voffA);
        if (wr == 1) PG8_BAR;
        PG8_WAIT_V(2); PG8_BAR;
        PG8_STAGE(PG8_SB(1, 0), cB + kstep, voffB); PG8_STAGE(PG8_SA(1, 0), cA + kstep, voffA); PG8_STAGE(PG8_SB(1, 1), cB + hstep + kstep, voffB);
        PG8_WAIT_V(6); PG8_BAR;
    } else {
        PG8_STAGE(PG8_SB(0, 0), cB, voffB); PG8_STAGE(PG8_SA(0, 0), cA, voffA); PG8_STAGE(PG8_SB(0, 1), cB + hstep, voffB); PG8_STAGE(PG8_SA(0, 1), cA + hstep, voffA);
        if (wr == 1) PG8_BAR;
        PG8_WAIT_V(4); PG8_BAR;
        PG8_STAGE(PG8_SB(1, 0), cB + kstep, voffB); PG8_STAGE(PG8_SA(1, 0), cA + kstep, voffA); PG8_STAGE(PG8_SB(1, 1), cB + hstep + kstep, voffB);
        PG8_WAIT_V(6); PG8_BAR;
    }
    for (;;) {
        const bool has_next = S.next(ui + 1, nxt);
        const char* nA = has_next ? (const char*)g.A + (size_t)nxt.pm * tstep : cA; const char* nB = has_next ? (const char*)g.Bt + (size_t)nxt.pn * tstep : cB;
        for (int t = 0; t < nt; t += 2) {
            const bool last = (t == nt - 2);
            const char* a1 = cA + (size_t)(t + 1) * kstep;
            const char* a2 = last ? nA : cA + (size_t)(t + 2) * kstep; const char* b2 = last ? nB : cB + (size_t)(t + 2) * kstep;
            const char* a3 = a2 + kstep; const char* b3 = b2 + kstep;
            if (last && has_next) S.a_ready(nxt);
            if constexpr (SP2) {
            PG8_LDB(B0, 0, 0); PG8_LDB(B1, 0, 1); PG8_SCHED; PG8_LDA(At, 0, 0); PG8_STAGE(PG8_SA(1, 1), a1 + hstep, voffA);
            PG8_WAIT_V(8); PG8_WAIT_L(0); PG8_BAR; PG8_MMA(0, 0, At, B0); PG8_MMA(0, 1, At, B1); PG8_BAR; PG8_SCHED;
            PG8_LDA(At, 0, 1); PG8_STAGE(PG8_SB(0, 0), b2, voffB); PG8_STAGE(PG8_SB(0, 1), b2 + hstep, voffB); PG8_STAGE(PG8_SA(0, 0), a2, voffA);
            PG8_WAIT_V(8); PG8_WAIT_L(0); PG8_BAR; PG8_MMA(1, 0, At, B0); PG8_MMA(1, 1, At, B1); PG8_BAR; PG8_SCHED;
            PG8_LDB(B0, 1, 0); PG8_LDB(B1, 1, 1); PG8_SCHED; PG8_LDA(At, 1, 0); PG8_STAGE(PG8_SA(0, 1), a2 + hstep, voffA);
            PG8_WAIT_V(8); PG8_WAIT_L(0); PG8_BAR; PG8_MMA(0, 0, At, B0); PG8_MMA(0, 1, At, B1); PG8_BAR; PG8_SCHED;
            PG8_LDA(At, 1, 1); PG8_STAGE(PG8_SB(1, 0), b3, voffB); PG8_STAGE(PG8_SB(1, 1), b3 + hstep, voffB); PG8_STAGE(PG8_SA(1, 0), a3, voffA);
            PG8_WAIT_V(8); PG8_WAIT_L(0); PG8_BAR; PG8_MMA(1, 0, At, B0); PG8_MMA(1, 1, At, B1); PG8_BAR; PG8_SCHED;
            } else {
            PG8_LDB(B0, 0, 0); PG8_SCHED; PG8_LDA(At, 0, 0); PG8_STAGE(PG8_SA(1, 1), a1 + hstep, voffA);
            PG8_WAIT_L(8); PG8_BAR; PG8_WAIT_L(0); PG8_MMA(0, 0, At, B0); PG8_BAR; PG8_SCHED;
            PG8_LDB(B1, 0, 1); PG8_STAGE(PG8_SB(0, 0), b2, voffB);
            PG8_BAR; PG8_WAIT_L(0); PG8_MMA(0, 1, At, B1); PG8_BAR;
            PG8_LDA(At, 0, 1); PG8_STAGE(PG8_SA(0, 0), a2, voffA);
            PG8_BAR; PG8_WAIT_L(0); PG8_MMA(1, 0, At, B0); PG8_BAR; PG8_SCHED;
            PG8_STAGE(PG8_SB(0, 1), b2 + hstep, voffB);
            PG8_WAIT_V(6); PG8_BAR; PG8_MMA(1, 1, At, B1); PG8_BAR;
            PG8_LDB(B0, 1, 0); PG8_SCHED; PG8_LDA(At, 1, 0); PG8_STAGE(PG8_SA(0, 1), a2 + hstep, voffA);
            PG8_WAIT_L(8); PG8_BAR; PG8_WAIT_L(0); PG8_MMA(0, 0, At, B0); PG8_BAR; PG8_SCHED;
            PG8_LDB(B1, 1, 1); PG8_STAGE(PG8_SB(1, 0), b3, voffB);
            PG8_BAR; PG8_WAIT_L(0); PG8_MMA(0, 1, At, B1); PG8_BAR;
            PG8_LDA(At, 1, 1); PG8_STAGE(PG8_SA(1, 0), a3, voffA);
            PG8_BAR; PG8_WAIT_L(0); PG8_MMA(1, 0, At, B0); PG8_BAR; PG8_SCHED;
            PG8_STAGE(PG8_SB(1, 1), b3 + hstep, voffB);
            PG8_WAIT_V(6); PG8_BAR; PG8_MMA(1, 1, At, B1); PG8_BAR;
            }
        }
        if constexpr (ALIGN_EPI) { if (wr == 0) PG8_BAR; }
        if constexpr (!Epi::AFTER_DRAIN) { E(acc, cur, wr, wc, fr, fq); S.done(cur); }
        if (!has_next) break;
#pragma unroll
        for (int a = 0; a < 2; ++a)
#pragma unroll
            for (int b = 0; b < 2; ++b)
#pragma unroll
                for (int m = 0; m < 4; ++m)
#pragma unroll
                    for (int n = 0; n < 2; ++n) acc[a][b][m][n] = (f32x4){0.f, 0.f, 0.f, 0.f};
        cur = nxt; cA = nA; cB = nB; ++ui;
        if constexpr (ALIGN_EPI) { if (wr == 1) PG8_BAR; }
    }
    PG8_WAIT_V(0);
    if constexpr (!ALIGN_EPI) { if (wr == 0) PG8_BAR; }
    PG8_BAR;
    if constexpr (Epi::AFTER_DRAIN) { E.fused(acc, cur, wr, wc, fr, fq, lds, wid, lane); S.done(cur); }
#undef PG8_SA
#undef PG8_SB
#undef PG8_STAGE
#undef PG8_LDA
#undef PG8_LDB
#undef PG8_MMA
#undef PG8_WAIT_V
#undef PG8_WAIT_L
#undef PG8_BAR
#undef PG8_SCHED
}
}

#define GAS __attribute__((address_space(1)))
#define LAS __attribute__((address_space(3)))
typedef unsigned short bf16;
typedef unsigned v4u __attribute__((ext_vector_type(4)));
typedef unsigned v2u __attribute__((ext_vector_type(2)));
typedef float f32x2 __attribute__((ext_vector_type(2)));
typedef float f32x4 __attribute__((ext_vector_type(4)));
typedef float f32x16 __attribute__((ext_vector_type(16)));
typedef short bf16x8 __attribute__((ext_vector_type(8)));
typedef short s16x4 __attribute__((ext_vector_type(4)));
typedef GAS unsigned gu32;
#define RLX_AGENT __ATOMIC_RELAXED, __HIP_MEMORY_SCOPE_AGENT
#define LDS_WAIT() asm volatile("s_waitcnt lgkmcnt(0)" ::: "memory")
#define VM_WAIT() asm volatile("s_waitcnt vmcnt(0)" ::: "memory")
#define SBAR() __builtin_amdgcn_sched_barrier(0)
using pg8::cvt_pk_bf16;
__device__ __forceinline__ float bflo(unsigned w) { return __uint_as_float(w << 16); }
__device__ __forceinline__ float bfhi(unsigned w) { return __uint_as_float(w & 0xffff0000u); }
__device__ __forceinline__ float silu_f(float x) { return x * __builtin_amdgcn_rcpf(1.0f + __builtin_amdgcn_exp2f(-1.4426950408889634f * x)); }
__device__ __forceinline__ f32x4 silu4(f32x4 v) { f32x4 r; r.x = silu_f(v.x); r.y = silu_f(v.y); r.z = silu_f(v.z); r.w = silu_f(v.w); return r; }
__device__ __forceinline__ v2u pack4(f32x4 v) { v2u r; r.x = cvt_pk_bf16(v.x, v.y); r.y = cvt_pk_bf16(v.z, v.w); return r; }
__device__ __forceinline__ v4u pack8(f32x4 a, f32x4 b) { v4u r; r.x = cvt_pk_bf16(a.x, a.y); r.y = cvt_pk_bf16(a.z, a.w); r.z = cvt_pk_bf16(b.x, b.y); r.w = cvt_pk_bf16(b.z, b.w); return r; }
__device__ __forceinline__ f32x4 unp_lo(v4u q) { return (f32x4){bflo(q.x), bfhi(q.x), bflo(q.y), bfhi(q.y)}; }
__device__ __forceinline__ f32x4 unp_hi(v4u q) { return (f32x4){bflo(q.z), bfhi(q.z), bflo(q.w), bfhi(q.w)}; }
__device__ __forceinline__ v4u zero4() { v4u z = {0u, 0u, 0u, 0u}; asm volatile("" : "+v"(z)); return z; }
template <int M> __device__ __forceinline__ float xor_lt32(float v) { return __builtin_bit_cast(float, __builtin_amdgcn_ds_swizzle(__builtin_bit_cast(int, v), (M << 10) | 0x1f)); }
__device__ __forceinline__ float sum_halves(float v) { const unsigned u = __builtin_bit_cast(unsigned, v); const auto r = __builtin_amdgcn_permlane32_swap(u, u, false, false);
    return __builtin_bit_cast(float, (unsigned)r[0]) + __builtin_bit_cast(float, (unsigned)r[1]); }
__device__ __forceinline__ float wave_sum(float v) {
    v += xor_lt32<1>(v); v += xor_lt32<2>(v); v += xor_lt32<4>(v); v += xor_lt32<8>(v); v += xor_lt32<16>(v);
    return sum_halves(v);
}

constexpr int DM = 2048, NPR = 4096, NSM = 32768, MT = 36864, KVR = 40960, KVS = 4608;
constexpr float EPS = 1e-6f;
constexpr int EVEN_IN = 11328, EVEN_NV = 11520, ODD_IN = 12288;
constexpr size_t MiB = 1u << 20;
constexpr size_t WS_CTL = 0, CTL_ZERO_BYTES = 65536;
constexpr size_t WS_MOD = 1 * MiB;
constexpr size_t WS_ROPE = 2 * MiB - 65536;
constexpr size_t WS_W = 2 * MiB;
constexpr size_t WE_IN = WS_W, WE_QB = WS_W + 45 * MiB, WE_KVB = WS_W + 48 * MiB, WE_OUT = WS_W + 52 * MiB;

constexpr size_t WS_CKV = 70 * MiB;
constexpr size_t WS_KPE = 110 * MiB;
constexpr size_t A0 = 116 * MiB;
constexpr size_t WS_MIX = A0, WS_QN = A0 + 288 * MiB, WS_HE = A0 + 324 * MiB, WS_PPB = A0 + 468 * MiB, WS_U1B = A0 + 504 * MiB, WS_QA = A0 + 592 * MiB, WS_CKVR = A0 + 628 * MiB;
constexpr size_t WS_Q = A0 + 324 * MiB, WS_KV = A0 + 432 * MiB;
constexpr size_t WS_HO = 2 * MiB, WS_STATS = 146 * MiB, WS_VR = 164 * MiB, WS_UG = 452 * MiB;
constexpr size_t WS_XB = 815 * MiB;
constexpr size_t WS_WO = 959 * MiB;
constexpr size_t WO_IN = WS_WO, WO_OUT = WS_WO + 48 * MiB, WO_S = WS_WO + 64 * MiB;
constexpr size_t WS_END = WS_WO + 65 * MiB;
static_assert(WS_CKVR + 36 * MiB <= WS_XB && WS_UG + 288 * MiB <= WS_XB && WS_XB + 144 * MiB <= WS_WO && WS_END == 1024 * MiB, "map");
static_assert(WS_MOD + 4 * 9 * 6144 * 4 <= WS_ROPE && WS_ROPE + 8192 <= WS_W, "map");
static_assert(WS_Q + (size_t)MT * 1536 * 2 <= WS_KV && WS_KV + (size_t)KVR * 2048 * 2 <= WS_QA, "map");
static_assert(WS_STATS + (size_t)MT * 64 * 8 <= WS_VR && WS_HO + 144 * MiB <= WS_STATS, "map");
constexpr int CW_TMO = 0, CW_BAR = 4096;
constexpr int RING_BYTES = 131072, LDSCTL_OFF = RING_BYTES, MISC_OFF = LDSCTL_OFF + 320, LDS_BYTES = 147456;

namespace att {
constexpr int KN_OFF = 0, KP_OFF = 16384, V_OFF = 24576, SLOT = 40960, SCR_OFF = 2 * SLOT, ATT_LDS = SCR_OFF + 8 * 256;
constexpr float SCALE = 0.07216878364870322f;
constexpr float THR = 8.f;
__device__ __forceinline__ int crow(int r, int hi) { return (r & 3) + 8 * (r >> 2) + 4 * hi; }
__device__ __forceinline__ unsigned cvtpk(float lo, float hi) { unsigned r; asm volatile("v_cvt_pk_bf16_f32 %0, %1, %2" : "=v"(r) : "v"(lo), "v"(hi)); return r; }
__device__ __forceinline__ void partialSM(f32x16& p0, f32x16& p1, float& m_reg, float& mn, float& alpha) {
  constexpr float C = SCALE * 1.4426950408889634f;
  float pmax = p0[0];
#pragma unroll
  for (int r = 1; r < 16; ++r) pmax = fmaxf(pmax, p0[r]);
#pragma unroll
  for (int r = 0; r < 16; ++r) pmax = fmaxf(pmax, p1[r]);
  { auto rr = __builtin_amdgcn_permlane32_swap(__float_as_uint(pmax), __float_as_uint(pmax), false, false);
    pmax = fmaxf(__uint_as_float(rr[0]), __uint_as_float(rr[1])); }
  if (__builtin_expect(__all(pmax - m_reg <= THR / SCALE), 1)) { mn = m_reg; alpha = 1.f; }
  else { mn = fmaxf(m_reg, pmax); alpha = __builtin_amdgcn_exp2f((m_reg - mn) * C); m_reg = mn; }
  float mnC = -mn * C;
#pragma unroll
  for (int r = 0; r < 16; ++r) p0[r] = fmaf(p0[r], C, mnC);
#pragma unroll
  for (int r = 0; r < 16; ++r) p1[r] = fmaf(p1[r], C, mnC);
#pragma unroll
  for (int r = 0; r < 16; ++r) p0[r] = __builtin_amdgcn_exp2f(p0[r]);
}
__device__ __forceinline__ void finishSM(f32x16& p0, f32x16& p1, float alpha, float& l_reg, bf16x8& pa0, bf16x8& pa1, bf16x8& pa2, bf16x8& pa3) {
#pragma unroll
  for (int r = 0; r < 16; ++r) p1[r] = __builtin_amdgcn_exp2f(p1[r]);
  float ps = 0;
#pragma unroll
  for (int r = 0; r < 16; ++r) ps += p0[r];
#pragma unroll
  for (int r = 0; r < 16; ++r) ps += p1[r];
  { auto rr = __builtin_amdgcn_permlane32_swap(__float_as_uint(ps), __float_as_uint(ps), false, false);
    ps = __uint_as_float(rr[0]) + __uint_as_float(rr[1]); }
  l_reg = l_reg * alpha + ps;
#define PK4(P, BASE, OUT) do { unsigned a0 = cvtpk(P[BASE + 0], P[BASE + 1]), a1 = cvtpk(P[BASE + 2], P[BASE + 3]);   \
    unsigned b0 = cvtpk(P[BASE + 4], P[BASE + 5]), b1 = cvtpk(P[BASE + 6], P[BASE + 7]);                              \
    auto r0 = __builtin_amdgcn_permlane32_swap(a0, b0, false, false); auto r1 = __builtin_amdgcn_permlane32_swap(a1, b1, false, false); \
    v4u w = {r0[0], r1[0], r0[1], r1[1]}; OUT = __builtin_bit_cast(bf16x8, w); } while (0)
  PK4(p0, 0, pa0); PK4(p0, 8, pa1); PK4(p1, 0, pa2); PK4(p1, 8, pa3);
#undef PK4
}
#ifndef QK_PF
#define QK_PF 3
#endif
#define ATT_ALL_QF 1
template <int OFF> __device__ __forceinline__ bf16x8 lds_rd128(int addr) { bf16x8 r; asm volatile("ds_read_b128 %0, %1 offset:%2" : "=v"(r) : "v"(addr), "i"(OFF)); return r; }
template <int N> __device__ __forceinline__ void lgkm_wait() { asm volatile("s_waitcnt lgkmcnt(%0)" :: "i"(N) : "memory"); __builtin_amdgcn_sched_barrier(0); }
template <int S> __device__ __forceinline__ void qkt(f32x16& p0, f32x16& p1, int kbn, int kbp, const bf16x8* qr) {
  p0 = f32x16{}; p1 = f32x16{};
  bf16x8 f0[12], f1[12];
#define LDK(d) do { if ((d) < 8) { const int a_ = kbn ^ ((d) << 5); f0[d] = lds_rd128<S * SLOT + KN_OFF>(a_); f1[d] = lds_rd128<S * SLOT + KN_OFF + 8192>(a_); } \
                    else { const int a_ = kbp ^ (((d) - 8) << 5); f0[d] = lds_rd128<S * SLOT + KP_OFF>(a_); f1[d] = lds_rd128<S * SLOT + KP_OFF + 4096>(a_); } } while (0)
#define QSTEP(d0) do { if ((d0) + QK_PF < 12) LDK((d0) + QK_PF); lgkm_wait<2 * ((d0) + QK_PF < 12 ? QK_PF : 11 - (d0))>(); \
    p0 = __builtin_amdgcn_mfma_f32_32x32x16_bf16(f0[d0], qr[d0], p0, 0, 0, 0); p1 = __builtin_amdgcn_mfma_f32_32x32x16_bf16(f1[d0], qr[d0], p1, 0, 0, 0); } while (0)
#pragma unroll
  for (int d = 0; d < QK_PF; ++d) LDK(d);
  QSTEP(0); QSTEP(1); QSTEP(2); QSTEP(3); QSTEP(4); QSTEP(5); QSTEP(6); QSTEP(7); QSTEP(8); QSTEP(9); QSTEP(10); QSTEP(11);
#undef QSTEP
#undef LDK
}
__device__ __forceinline__ int v_st(int k, int c) { const int kk = (k & ~0xC) | ((k & 4) << 1) | ((k & 8) >> 1); return ((kk >> 3) * 4 + (c >> 5)) * 512 + ((kk & 7) * 32 + (c & 31)) * 2; }
__device__ __forceinline__ int v_rd_base(int lane) { return ((lane & 3) << 3) | (((lane >> 2) & 3) << 6) | (((lane >> 4) & 1) << 5) | (((lane >> 5) & 1) << 8); }
constexpr int v_rd_off(int d0, int ks, int half) { return d0 * 512 + ks * 4096 + half * 2048; }
template <int OFF> __device__ __forceinline__ s16x4 tr_read(int vb) {
  s16x4 r; asm volatile("ds_read_b64_tr_b16 %0, %1 offset:%2" : "=&v"(r) : "v"(vb), "i"(OFF) : "memory"); return r;
}
struct VGrp { s16x4 l0, h0, l1, h1, l2, h2, l3, h3; };
template <int D0> __device__ __forceinline__ void v_load(VGrp& g, int vb) {
  g.l0 = tr_read<v_rd_off(D0, 0, 0)>(vb); g.h0 = tr_read<v_rd_off(D0, 0, 1)>(vb); g.l1 = tr_read<v_rd_off(D0, 1, 0)>(vb); g.h1 = tr_read<v_rd_off(D0, 1, 1)>(vb);
  g.l2 = tr_read<v_rd_off(D0, 2, 0)>(vb); g.h2 = tr_read<v_rd_off(D0, 2, 1)>(vb); g.l3 = tr_read<v_rd_off(D0, 3, 0)>(vb); g.h3 = tr_read<v_rd_off(D0, 3, 1)>(vb);
}
struct StepDma { const unsigned char* kn; const unsigned char* kp; const unsigned char* vp; LAS unsigned char* lk; LAS unsigned char* lv; unsigned okn, okp, ov; bool doK; };
#define ATT_GLDS_(gp, lp) __builtin_amdgcn_global_load_lds((const unsigned*)(gp), (LAS unsigned*)(lp), 16, 0, 0)
#define ATT_GLDS_AT(base, off, lp) do { unsigned o_ = (off); asm volatile("" : "+v"(o_)); __builtin_amdgcn_global_load_lds((const unsigned*)((base) + o_), (LAS unsigned*)(lp), 16, 0, 0); } while (0)
template <int S> __device__ __forceinline__ void qkt_fin(f32x16& n0, f32x16& n1, int kbn, int kbp, const bf16x8* qr,
                                                       f32x16& p0, f32x16& p1, float alpha, float& l_reg, bf16x8& pa0, bf16x8& pa1, bf16x8& pa2, bf16x8& pa3, const StepDma& dm, int vb, VGrp& va) {
  n0 = f32x16{}; n1 = f32x16{};
  bf16x8 f0[12], f1[12]; float s0, s1, s2, s3;
#define LDK(d) do { if ((d) < 8) { const int a_ = kbn ^ ((d) << 5); f0[d] = lds_rd128<S * SLOT + KN_OFF>(a_); f1[d] = lds_rd128<S * SLOT + KN_OFF + 8192>(a_); } \
                    else { const int a_ = kbp ^ (((d) - 8) << 5); f0[d] = lds_rd128<S * SLOT + KP_OFF>(a_); f1[d] = lds_rd128<S * SLOT + KP_OFF + 4096>(a_); } } while (0)
#define QSTEP(d0) do { if ((d0) + QK_PF < 12) LDK((d0) + QK_PF); lgkm_wait<2 * ((d0) + QK_PF < 12 ? QK_PF : 11 - (d0))>(); \
    n0 = __builtin_amdgcn_mfma_f32_32x32x16_bf16(f0[d0], qr[d0], n0, 0, 0, 0); n1 = __builtin_amdgcn_mfma_f32_32x32x16_bf16(f1[d0], qr[d0], n1, 0, 0, 0); } while (0)
#define QSTEPV(d0) do { lgkm_wait<2 * (11 - (d0)) + 8>();   \
    n0 = __builtin_amdgcn_mfma_f32_32x32x16_bf16(f0[d0], qr[d0], n0, 0, 0, 0); n1 = __builtin_amdgcn_mfma_f32_32x32x16_bf16(f1[d0], qr[d0], n1, 0, 0, 0); } while (0)
#define EXP4(b) do { p1[b] = __builtin_amdgcn_exp2f(p1[b]); p1[b + 1] = __builtin_amdgcn_exp2f(p1[b + 1]); p1[b + 2] = __builtin_amdgcn_exp2f(p1[b + 2]); p1[b + 3] = __builtin_amdgcn_exp2f(p1[b + 3]); } while (0)
#define SUM8(P, b) (((P[b] + P[b + 1]) + (P[b + 2] + P[b + 3])) + ((P[b + 4] + P[b + 5]) + (P[b + 6] + P[b + 7])))
#define PK4(P, BASE, OUT) do { unsigned a0 = cvtpk(P[BASE + 0], P[BASE + 1]), a1 = cvtpk(P[BASE + 2], P[BASE + 3]);   \
    unsigned b0 = cvtpk(P[BASE + 4], P[BASE + 5]), b1 = cvtpk(P[BASE + 6], P[BASE + 7]);                              \
    auto r0 = __builtin_amdgcn_permlane32_swap(a0, b0, false, false); auto r1 = __builtin_amdgcn_permlane32_swap(a1, b1, false, false); \
    v4u w = {r0[0], r1[0], r0[1], r1[1]}; OUT = __builtin_bit_cast(bf16x8, w); } while (0)
#pragma unroll
  for (int d = 0; d < QK_PF; ++d) LDK(d);
  QSTEP(0); s0 = SUM8(p0, 0); if (dm.doK) ATT_GLDS_AT(dm.kn, dm.okn, dm.lk + KN_OFF);
  QSTEP(1); s1 = SUM8(p0, 8); if (dm.doK) ATT_GLDS_AT(dm.kn + 32 * 4096, dm.okn, dm.lk + KN_OFF + 8192);
  QSTEP(2); PK4(p0, 0, pa0);  if (dm.doK) ATT_GLDS_AT(dm.kp, dm.okp, dm.lk + KP_OFF);
  QSTEP(3); PK4(p0, 8, pa1);  ATT_GLDS_AT(dm.vp, dm.ov, dm.lv);
  QSTEP(4); EXP4(0);          ATT_GLDS_AT(dm.vp + 32 * 4096, dm.ov, dm.lv + 8192);
  QSTEP(5); EXP4(4);
  QSTEP(6); EXP4(8);
  QSTEP(7); EXP4(12);
  QSTEP(8); s2 = SUM8(p1, 0);
  QSTEP(9); s3 = SUM8(p1, 8);
  { float ps = (s0 + s1) + (s2 + s3); auto rr = __builtin_amdgcn_permlane32_swap(__float_as_uint(ps), __float_as_uint(ps), false, false);
    ps = __uint_as_float(rr[0]) + __uint_as_float(rr[1]); l_reg = l_reg * alpha + ps; }
  v_load<0>(va, vb);
  QSTEPV(10); PK4(p1, 0, pa2);
  QSTEPV(11); PK4(p1, 8, pa3);
#undef QSTEPV
#undef PK4
#undef SUM8
#undef EXP4
#undef QSTEP
#undef LDK
}
template <int N> __device__ __forceinline__ void v_wait() { asm volatile("s_waitcnt lgkmcnt(%0)" :: "i"(N) : "memory"); SBAR(); }
__device__ __forceinline__ void v_mma(f32x16& od, const VGrp& g, bf16x8 pa0, bf16x8 pa1, bf16x8 pa2, bf16x8 pa3) {
#define PK(L, H) (bf16x8){L[0], L[1], L[2], L[3], H[0], H[1], H[2], H[3]}
  od = __builtin_amdgcn_mfma_f32_32x32x16_bf16(pa0, PK(g.l0, g.h0), od, 0, 0, 0);
  od = __builtin_amdgcn_mfma_f32_32x32x16_bf16(pa1, PK(g.l1, g.h1), od, 0, 0, 0);
  od = __builtin_amdgcn_mfma_f32_32x32x16_bf16(pa2, PK(g.l2, g.h2), od, 0, 0, 0);
  od = __builtin_amdgcn_mfma_f32_32x32x16_bf16(pa3, PK(g.l3, g.h3), od, 0, 0, 0);
#undef PK
}
__device__ __forceinline__ void pv_d0(f32x16* o, int vb, bf16x8 pa0, bf16x8 pa1, bf16x8 pa2, bf16x8 pa3) {
  VGrp a, b;
  v_load<0>(a, vb); v_load<1>(b, vb);
  v_wait<8>(); v_mma(o[0], a, pa0, pa1, pa2, pa3); SBAR();
  v_load<2>(a, vb);
  v_wait<8>(); v_mma(o[1], b, pa0, pa1, pa2, pa3); SBAR();
  v_load<3>(b, vb);
  v_wait<8>(); v_mma(o[2], a, pa0, pa1, pa2, pa3); SBAR();
  v_wait<0>(); v_mma(o[3], b, pa0, pa1, pa2, pa3);
}
__device__ __forceinline__ void pv_part(f32x16* o, int vb, VGrp& a  , bf16x8 pa0, bf16x8 pa1, bf16x8 pa2, bf16x8 pa3, f32x16& p0, f32x16& p1, float& m_reg, float& alpha) {
  constexpr float C = SCALE * 1.4426950408889634f;
  VGrp b;
  v_load<1>(b, vb);
  v_wait<8>(); v_mma(o[0], a, pa0, pa1, pa2, pa3);
  float pmax = fmaxf(p0[0], p0[1]);
#pragma unroll
  for (int r = 2; r < 16; ++r) pmax = fmaxf(pmax, p0[r]);
#pragma unroll
  for (int r = 0; r < 16; ++r) pmax = fmaxf(pmax, p1[r]);
  asm volatile("" : "+v"(pmax)); SBAR();
  v_load<2>(a, vb);
  v_wait<8>(); v_mma(o[1], b, pa0, pa1, pa2, pa3);
  { auto rr = __builtin_amdgcn_permlane32_swap(__float_as_uint(pmax), __float_as_uint(pmax), false, false); pmax = fmaxf(__uint_as_float(rr[0]), __uint_as_float(rr[1])); }
  const bool keep = __all(pmax - m_reg <= THR / SCALE);
  const float mn = keep ? m_reg : fmaxf(m_reg, pmax);
  alpha = __builtin_amdgcn_exp2f((m_reg - mn) * C); m_reg = mn;
  const float mnC = -mn * C;
#pragma unroll
  for (int r = 0; r < 16; ++r) p0[r] = fmaf(p0[r], C, mnC);
  asm volatile("" : "+v"(p0)); SBAR();
  v_load<3>(b, vb);
  v_wait<8>(); v_mma(o[2], a, pa0, pa1, pa2, pa3);
#pragma unroll
  for (int r = 0; r < 16; ++r) p1[r] = fmaf(p1[r], C, mnC);
#pragma unroll
  for (int r = 0; r < 6; ++r) p0[r] = __builtin_amdgcn_exp2f(p0[r]);
  asm volatile("" : "+v"(p0), "+v"(p1)); SBAR();
  v_wait<0>(); v_mma(o[3], b, pa0, pa1, pa2, pa3);
#pragma unroll
  for (int r = 6; r < 16; ++r) p0[r] = __builtin_amdgcn_exp2f(p0[r]);
  asm volatile("" : "+v"(p0));
}
#define ATT_GLDS(gp, lp) __builtin_amdgcn_global_load_lds((const unsigned*)(gp), (LAS unsigned*)(lp), 16, 0, 0)
#define ATT_BAR() do { asm volatile("" ::: "memory"); __builtin_amdgcn_s_barrier(); asm volatile("" ::: "memory"); } while (0)
__device__ __forceinline__ void unit(LAS unsigned char* lds, const bf16* __restrict__ Qb, int ldq, const unsigned char* __restrict__ Kn, const unsigned char* __restrict__ Vp, const unsigned char* __restrict__ Kp,
                                     int NT, bf16* Ob, int ldo, const bf16* Gb, int ldg) {
  int tid_ = threadIdx.x; asm volatile("" : "+v"(tid_));
  const int tid = tid_, wid = __builtin_amdgcn_readfirstlane(tid >> 6), lane = tid & 63, r32 = lane & 31, hi = lane >> 5;
  LAS float* scr = (LAS float*)(lds + SCR_OFF) + wid * 64; LAS float* li_l = scr; LAS float* al_l = scr + 32;
  float m_reg = -1e30f, l_reg = 0.f; f32x16 o[4] = {}; bf16x8 qr[12];
  { const bf16* Qw = Qb + (size_t)(wid * 32 + r32) * ldq + hi * 8;
#pragma unroll
    for (int d0 = 0; d0 < 12; ++d0) qr[d0] = *(const bf16x8*)(Qw + d0 * 16); }
  const unsigned offKn = (unsigned)((4 * wid + (lane >> 4)) * 4096 + (((lane & 15) ^ ((4 * wid + (lane >> 4)) & 15)) << 4));
  const unsigned offKp = (unsigned)((8 * wid + (lane >> 3)) * 128 + (((lane & 7) ^ (((8 * wid + (lane >> 3)) >> 1) & 7)) << 4));
  unsigned offV; { const int kk = 8 * (wid >> 1) + ((lane & 31) >> 2); const int k = (kk & ~0xC) | ((kk & 4) << 1) | ((kk & 8) >> 1); const int c = (2 * (wid & 1) + (lane >> 5)) * 32 + 8 * (lane & 3); offV = (unsigned)(k * 4096 + c * 2); }
  const int vb0 = (int)(unsigned)(uintptr_t)(lds + V_OFF) + v_rd_base(lane);
  const int kbn = (int)(unsigned)(uintptr_t)lds + r32 * 256 + ((hi ^ (r32 & 1)) << 4) + (((r32 & 15) >> 1) << 5);
  const int kbp = (int)(unsigned)(uintptr_t)lds + r32 * 128 + ((hi ^ ((r32 >> 1) & 1)) << 4) + ((((r32 >> 1) & 7) >> 1) << 5);
#define ISSUE_K(j, s) do { const unsigned char* g_ = Kn + (size_t)(j) * (64 * 4096) + offKn; LAS unsigned char* l_ = lds + (s) * SLOT + KN_OFF + wid * 1024; \
    ATT_GLDS(g_, l_); ATT_GLDS(g_ + 32 * 4096, l_ + 8192); ATT_GLDS(Kp + (size_t)(j) * (64 * 128) + offKp, lds + (s) * SLOT + KP_OFF + wid * 1024); } while (0)
#define ISSUE_V(j, s) do { const unsigned char* g_ = Vp + (size_t)(j) * (64 * 4096) + offV; LAS unsigned char* l_ = lds + (s) * SLOT + V_OFF + wid * 1024; \
    ATT_GLDS(g_, l_); ATT_GLDS(g_ + 32 * 4096, l_ + 8192); } while (0)
#define RESC(a) do { if (__any((a) < 1.f)) { if (hi == 0) al_l[r32] = (a); asm volatile("s_waitcnt lgkmcnt(0)" ::: "memory"); \
    _Pragma("unroll") for (int d = 0; d < 4; ++d) _Pragma("unroll") for (int r = 0; r < 16; ++r) o[d][r] *= al_l[crow(r, hi)]; } } while (0)
#define STEP_END() do { asm volatile("s_waitcnt vmcnt(0)" ::: "memory"); ATT_BAR(); } while (0)
  f32x16 pA0, pA1, pB0, pB1; float mnA, mnB, alA, alB; bf16x8 pa0, pa1, pa2, pa3;
#define STEP_QF(N0, N1, mnN, alN, P0, P1, alP, kslot, vbase, DM) do { VGrp va_; SBAR(); qkt_fin<kslot>(N0, N1, kbn, kbp, qr, P0, P1, alP, l_reg, pa0, pa1, pa2, pa3, DM, vbase, va_); SBAR(); \
    pv_part(o, vbase, va_, pa0, pa1, pa2, pa3, N0, N1, m_reg, alN); SBAR(); RESC(alN); } while (0)
#define MK_DMA(jk, sk, jv, sv, dok) StepDma{Kn + (size_t)(jk) * (64 * 4096), Kp + (size_t)(jk) * (64 * 128), Vp + (size_t)(jv) * (64 * 4096), \
    lds + (sk) * SLOT + wid * 1024, lds + (sv) * SLOT + V_OFF + wid * 1024, offKn, offKp, offV, (dok)}
#define MAINLOOP_QF() do { \
  ISSUE_K(0, 0); STEP_END(); \
  ISSUE_K(1, 1); ISSUE_V(0, 0); \
  qkt<0>(pA0, pA1, kbn, kbp, qr); partialSM(pA0, pA1, m_reg, mnA, alA); \
  STEP_END(); \
  for (int j = 1; j + 1 < NT; j += 2) { \
    { const StepDma dm_ = MK_DMA(j + 1, 0, j, 1, true); STEP_QF(pB0, pB1, mnB, alB, pA0, pA1, alA, 1, vb0, dm_); } STEP_END(); \
    { const StepDma dm_ = MK_DMA(j + 2, 1, j + 1, 0, j + 2 < NT); STEP_QF(pA0, pA1, mnA, alA, pB0, pB1, alB, 0, vb0 + SLOT, dm_); } STEP_END(); \
  } \
  { const StepDma dm_ = MK_DMA(NT - 1, 0, NT - 1, 1, false); STEP_QF(pB0, pB1, mnB, alB, pA0, pA1, alA, 1, vb0, dm_); } STEP_END(); \
  finishSM(pB0, pB1, alB, l_reg, pa0, pa1, pa2, pa3); SBAR(); \
  pv_d0(o, vb0 + SLOT, pa0, pa1, pa2, pa3); } while (0)
#define STEP_FQ(N0, N1, mnN, alN, P0, P1, alP, kslot, vbase) do { finishSM(P0, P1, alP, l_reg, pa0, pa1, pa2, pa3); SBAR(); pv_d0(o, vbase, pa0, pa1, pa2, pa3); SBAR(); \
    qkt<kslot>(N0, N1, kbn, kbp, qr); partialSM(N0, N1, m_reg, mnN, alN); RESC(alN); } while (0)
#define MAINLOOP(STEP) do { \
  ISSUE_K(0, 0); STEP_END(); \
  ISSUE_K(1, 1); ISSUE_V(0, 0); \
  qkt<0>(pA0, pA1, kbn, kbp, qr); partialSM(pA0, pA1, m_reg, mnA, alA); \
  STEP_END(); \
  for (int j = 1; j + 1 < NT; j += 2) { \
    ISSUE_K(j + 1, 0); ISSUE_V(j, 1); \
    STEP(pB0, pB1, mnB, alB, pA0, pA1, alA, 1, vb0); STEP_END(); \
    if (j + 2 < NT) ISSUE_K(j + 2, 1); \
    ISSUE_V(j + 1, 0); \
    STEP(pA0, pA1, mnA, alA, pB0, pB1, alB, 0, vb0 + SLOT); STEP_END(); \
  } \
  ISSUE_V(NT - 1, 1); \
  STEP(pB0, pB1, mnB, alB, pA0, pA1, alA, 1, vb0); STEP_END(); \
  finishSM(pB0, pB1, alB, l_reg, pa0, pa1, pa2, pa3); SBAR(); \
  pv_d0(o, vb0 + SLOT, pa0, pa1, pa2, pa3); } while (0)
#if defined(ATT_ALL_QF)
  MAINLOOP_QF();
#elif defined(ATT_ALL_FQ)
  MAINLOOP(STEP_FQ);
#else
  MAINLOOP(STEP_FQ);
#endif
#undef MAINLOOP
#undef MAINLOOP_QF
#undef MK_DMA
#undef STEP_QF
#undef STEP_FQ
  if (hi == 0) li_l[r32] = l_reg; asm volatile("s_waitcnt lgkmcnt(0)" ::: "memory");
  float rli[16];
#pragma unroll
  for (int r = 0; r < 16; ++r) rli[r] = __builtin_amdgcn_rcpf(li_l[crow(r, hi)]);
  ATT_BAR();
  { LAS unsigned char* stg = lds + wid * 8192;
#pragma unroll
    for (int r = 0; r < 16; ++r) {
#pragma unroll
      for (int d0 = 0; d0 < 4; ++d0) *(LAS bf16*)(stg + crow(r, hi) * 256 + (d0 * 32 + r32) * 2) = (bf16)(cvtpk(o[d0][r] * rli[r], 0.f) & 0xffffu); }
    asm volatile("s_waitcnt lgkmcnt(0)" ::: "memory");
#pragma unroll
    for (int j = 0; j < 8; ++j) { const int id = lane + 64 * j, row = id >> 4, cg = id & 15, orow = wid * 32 + row;
      const v4u a = *(const LAS v4u*)(stg + row * 256 + cg * 16), g = *(const v4u*)(Gb + (size_t)orow * ldg + cg * 8);
      v4u w; w.x = cvtpk(bflo(a.x) * bflo(g.x), bfhi(a.x) * bfhi(g.x)); w.y = cvtpk(bflo(a.y) * bflo(g.y), bfhi(a.y) * bfhi(g.y));
      w.z = cvtpk(bflo(a.z) * bflo(g.z), bfhi(a.z) * bfhi(g.z)); w.w = cvtpk(bflo(a.w) * bflo(g.w), bfhi(a.w) * bfhi(g.w));
      *(v4u*)(Ob + (size_t)orow * ldo + cg * 8) = w; } }
  ATT_BAR();
#undef ISSUE_K
#undef ISSUE_V
#undef RESC
#undef STEP_END
}
}

namespace pg8 {
__device__ __forceinline__ float dpp_shr1(float v) { return __builtin_bit_cast(float, __builtin_amdgcn_update_dpp(0, __builtin_bit_cast(int, v), 0x111, 0xf, 0xf, true)); }
__device__ __forceinline__ float dpp_shl1(float v) { return __builtin_bit_cast(float, __builtin_amdgcn_update_dpp(0, __builtin_bit_cast(int, v), 0x101, 0xf, 0xf, true)); }
__device__ __forceinline__ int kvrow_of(int row) { return row < NPR ? row : NPR + ((row - NPR) >> 12) * KVS + 512 + ((row - NPR) & 4095); }
struct EpiEvenIn {
    static constexpr bool PERM = false, AFTER_DRAIN = false;
    bf16 *MIX, *PPB, *U1B, *QA, *CKVR, *KPE; float* nkpe; const float* rope; const float* cw;
    __device__ __forceinline__ void operator()(const f32x4 (&acc)[2][2][4][2], const Unit& u, int wr, int wc, int fr, int fq) const {
        const int row0 = u.pm * BM + wr * 64 + fr, pn = u.pn;
        if (pn < 32) {
            const int ch = 64 * pn + 16 * wc + 4 * fq;
            const f32x4 w0 = *(const f32x4*)(cw + ch), w1 = *(const f32x4*)(cw + 2048 + ch), w2 = *(const f32x4*)(cw + 4096 + ch);
            const bool edge = fr == 0 || fr == 15, nearb = edge || fr == 1 || fr == 14; const int slot = fr < 2 ? fr : fr - 12;
#pragma unroll
            for (int ai = 0; ai < 2; ++ai)
#pragma unroll
                for (int m = 0; m < 4; ++m) { const int row = row0 + ai * HALF + m * 16;
                    const f32x4 cb = acc[ai][0][m][0], cc = acc[ai][0][m][1], cx = acc[ai][1][m][0], cg = acc[ai][1][m][1];
                    const f32x4 p = cc * cx, u1 = cb * silu4(cg);
                    const f32x4 pm = {dpp_shr1(p.x), dpp_shr1(p.y), dpp_shr1(p.z), dpp_shr1(p.w)};
                    const f32x4 pp = {dpp_shl1(p.x), dpp_shl1(p.y), dpp_shl1(p.z), dpp_shl1(p.w)};
                    if (!edge) *(v2u*)(MIX + (size_t)row * 4096 + ch) = pack4(u1 * (w0 * pm + w1 * p + w2 * pp));
                    if (nearb) *(v2u*)(PPB + ((size_t)(row >> 4) * 4 + slot) * 2048 + ch) = pack4(p);
                    if (edge) *(v2u*)(U1B + ((size_t)(row >> 4) * 2 + (fr == 15 ? 1 : 0)) * 2048 + ch) = pack4(u1); }
        } else if (pn < 36) {
            bf16* dst = pn < 34 ? QA : CKVR; const int col = (pn & 1) * 256 + 32 * wc + 8 * fq;
#pragma unroll
            for (int ai = 0; ai < 2; ++ai)
#pragma unroll
                for (int m = 0; m < 4; ++m) { bf16* rp = dst + (size_t)(row0 + ai * HALF + m * 16) * 512 + col;
#pragma unroll
                    for (int bj = 0; bj < 2; ++bj) *(v4u*)(rp + bj * HALF) = pack8(acc[ai][bj][m][0], acc[ai][bj][m][1]); }
        } else if (pn == 36) {
            if (wc < 2) {
#pragma unroll
                for (int ai = 0; ai < 2; ++ai)
#pragma unroll
                    for (int m = 0; m < 4; ++m) { const int row = row0 + ai * HALF + m * 16; f32x4 x0 = acc[ai][0][m][0], x1 = acc[ai][0][m][1];
                        if (row < NPR) { float* op = nkpe + (size_t)(row >> 8) * (2 * 256 * 64) + (row & 255) * 64 + 32 * wc + 4 * fq; *(f32x4*)op = x0; *(f32x4*)(op + 16) = x1; }
                        else { const int nt = (row - NPR) & 4095, pos = wc == 0 ? (nt >> 6) : (nt & 63); const float* cs = rope + (pos * 16 + 4 * fq) * 2;
                            const f32x4 t0 = *(const f32x4*)cs, t1 = *(const f32x4*)(cs + 4); const f32x4 c = {t0.x, t0.z, t1.x, t1.z}, s = {t0.y, t0.w, t1.y, t1.w};
                            const f32x4 y0 = x0 * c - x1 * s, y1 = x1 * c + x0 * s; x0 = y0; x1 = y1; }
                        bf16* kp = KPE + (size_t)kvrow_of(row) * 64 + 32 * wc + 4 * fq; *(v2u*)kp = pack4(x0); *(v2u*)(kp + 16) = pack4(x1); }
            }
        } else {
            const int col = 2048 + (pn - 37) * 256 + 32 * wc + 8 * fq;
#pragma unroll
            for (int ai = 0; ai < 2; ++ai)
#pragma unroll
                for (int m = 0; m < 4; ++m) { bf16* rp = MIX + (size_t)(row0 + ai * HALF + m * 16) * 4096 + col;
#pragma unroll
                    for (int bj = 0; bj < 2; ++bj) *(v4u*)(rp + bj * HALF) = pack8(silu4(acc[ai][bj][m][0]), silu4(acc[ai][bj][m][1])); }
        }
    }
};
struct EpiStore {
    static constexpr bool PERM = false, AFTER_DRAIN = false;
    bf16* O; int ldc;
    __device__ __forceinline__ void operator()(const f32x4 (&acc)[2][2][4][2], const Unit& u, int wr, int wc, int fr, int fq) const {
        const int row0 = u.pm * BM + wr * 64 + fr, col = u.pn * BM + 32 * wc + 8 * fq;
#pragma unroll
        for (int ai = 0; ai < 2; ++ai)
#pragma unroll
            for (int m = 0; m < 4; ++m) { bf16* rp = O + (size_t)(row0 + ai * HALF + m * 16) * ldc + col;
#pragma unroll
                for (int bj = 0; bj < 2; ++bj) *(v4u*)(rp + bj * HALF) = pack8(acc[ai][bj][m][0], acc[ai][bj][m][1]); }
    }
};
struct EpiQ {
    static constexpr bool PERM = false, AFTER_DRAIN = false;
    bf16* Q; const float* rope;
    __device__ __forceinline__ void operator()(const f32x4 (&acc)[2][2][4][2], const Unit& u, int wr, int wc, int fr, int fq) const {
        const int row0 = u.pm * BM + wr * 64 + fr;
#pragma unroll
        for (int bj = 0; bj < 2; ++bj) { const int gi = 8 * u.pn + 4 * bj + wc, hl = gi / 6, sub = gi - 6 * hl;
            if (sub < 4) {
#pragma unroll
                for (int ai = 0; ai < 2; ++ai)
#pragma unroll
                    for (int m = 0; m < 4; ++m) *(v4u*)(Q + (size_t)(row0 + ai * HALF + m * 16) * 1536 + hl * 192 + 32 * sub + 8 * fq) = pack8(acc[ai][bj][m][0], acc[ai][bj][m][1]);
            } else { const int h = sub - 4;
#pragma unroll
                for (int ai = 0; ai < 2; ++ai)
#pragma unroll
                    for (int m = 0; m < 4; ++m) { const int row = row0 + ai * HALF + m * 16; f32x4 x0 = acc[ai][bj][m][0], x1 = acc[ai][bj][m][1];
                        if (row >= NPR) { const int nt = (row - NPR) & 4095, pos = h == 0 ? (nt >> 6) : (nt & 63); const float* cs = rope + (pos * 16 + 4 * fq) * 2;
                            const f32x4 t0 = *(const f32x4*)cs, t1 = *(const f32x4*)(cs + 4); const f32x4 c = {t0.x, t0.z, t1.x, t1.z}, s = {t0.y, t0.w, t1.y, t1.w};
                            const f32x4 y0 = x0 * c - x1 * s, y1 = x1 * c + x0 * s; x0 = y0; x1 = y1; }
                        bf16* qp = Q + (size_t)row * 1536 + hl * 192 + 128 + 32 * h + 4 * fq; *(v2u*)qp = pack4(x0); *(v2u*)(qp + 16) = pack4(x1); }
            }
        }
    }
};
struct EpiResid {
    static constexpr bool PERM = false, AFTER_DRAIN = false;
    const float* xp; const float* xs; bf16* xb; float* xo; const float* gate; int first, last;
    __device__ __forceinline__ void operator()(const f32x4 (&acc)[2][2][4][2], const Unit& u, int wr, int wc, int fr, int fq) const {
        const int row0 = u.pm * BM + wr * 64 + fr, col0 = u.pn * BM + wc * 32 + 8 * fq;
        const int cr = u.pm < 16 ? 0 : 1 + ((u.pm - 16) >> 4);
        const float* xin = u.pm < 16 ? xp : xs - (size_t)NPR * DM;
        const float* gp = gate + (size_t)cr * 6144 + col0;
        f32x4 gv[2][2];
#pragma unroll
        for (int bj = 0; bj < 2; ++bj)
#pragma unroll
            for (int n = 0; n < 2; ++n) gv[bj][n] = *(const f32x4*)(gp + bj * HALF + n * 4);
#pragma unroll
        for (int ai = 0; ai < 2; ++ai)
#pragma unroll
            for (int m = 0; m < 4; ++m) { const size_t off = (size_t)(row0 + ai * HALF + m * 16) * DM + col0;
#pragma unroll
                for (int bj = 0; bj < 2; ++bj) { f32x4 a, b;
                    if (first) { a = *(const f32x4*)(xin + off + bj * HALF); b = *(const f32x4*)(xin + off + bj * HALF + 4); }
                    else { const v4u w = *(const v4u*)(xb + off + bj * HALF); a = (f32x4){bflo(w.x), bfhi(w.x), bflo(w.y), bfhi(w.y)}; b = (f32x4){bflo(w.z), bfhi(w.z), bflo(w.w), bfhi(w.w)}; }
                    a += gv[bj][0] * acc[ai][bj][m][0]; b += gv[bj][1] * acc[ai][bj][m][1];
                    if (last) { *(f32x4*)(xo + off + bj * HALF) = a; *(f32x4*)(xo + off + bj * HALF + 4) = b; }
                    else *(v4u*)(xb + off + bj * HALF) = pack8(a, b); }
                asm volatile("" ::: "memory"); }
    }
};
struct EpiOddIn {
    static constexpr bool PERM = false, AFTER_DRAIN = false;
    bf16 *UG, *VR; float* stats;
    __device__ __forceinline__ void operator()(const f32x4 (&acc)[2][2][4][2], const Unit& u, int wr, int wc, int fr, int fq) const {
        const int row0 = u.pm * BM + wr * 64 + fr, pn = u.pn;
        if (pn < 32) {
            const int col = 128 * pn + 32 * wc + 8 * fq;
#pragma unroll
            for (int ai = 0; ai < 2; ++ai)
#pragma unroll
                for (int m = 0; m < 4; ++m) *(v4u*)(UG + (size_t)(row0 + ai * HALF + m * 16) * 4096 + col) = pack8(acc[ai][0][m][0] * silu4(acc[ai][1][m][0]), acc[ai][0][m][1] * silu4(acc[ai][1][m][1]));
        } else {
            const int col = (pn - 32) * 256 + 32 * wc + 8 * fq;
#pragma unroll
            for (int ai = 0; ai < 2; ++ai)
#pragma unroll
                for (int m = 0; m < 4; ++m) { const int row = row0 + ai * HALF + m * 16; bf16* rp = VR + (size_t)row * 4096 + col; float s = 0.f, q = 0.f;
#pragma unroll
                    for (int bj = 0; bj < 2; ++bj) { const f32x4 a = acc[ai][bj][m][0], b = acc[ai][bj][m][1]; *(v4u*)(rp + bj * HALF) = pack8(a, b);
                        s += (a.x + a.y) + (a.z + a.w) + (b.x + b.y) + (b.z + b.w); q += (a.x * a.x + a.y * a.y) + (a.z * a.z + a.w * a.w) + (b.x * b.x + b.y * b.y) + (b.z * b.z + b.w * b.w); }
                    s += xor_lt32<16>(s); s = sum_halves(s); q += xor_lt32<16>(q); q = sum_halves(q);
                    if (fq == 0) *(f32x2*)(stats + ((size_t)row * 64 + (pn - 32) * 4 + wc) * 2) = (f32x2){s, q}; }
        }
    }
};
}

#define XB_TMO      128
#define XB_XCNT(j)  (256  + 64 * (j))
#define XB_XSUB(j)  (1280 + 64 * (j))
#define XB_XGEN(j)  (2304 + 64 * (j))
#define XB_TOP      3328
#define XB_TOPGEN   3392
#define XCD_BAR_WORDS 3456
#define XB_SPIN_CAP (1u << 18)

__device__ __forceinline__ unsigned xb_ld(unsigned* p)              { return __hip_atomic_load(p, __ATOMIC_RELAXED, __HIP_MEMORY_SCOPE_AGENT); }
__device__ __forceinline__ unsigned xb_add(unsigned* p, unsigned v) { return __hip_atomic_fetch_add(p, v, __ATOMIC_RELAXED, __HIP_MEMORY_SCOPE_AGENT); }
__device__ __forceinline__ unsigned xb_xcc_id() { return (unsigned)__builtin_amdgcn_s_getreg((3 << 11) | 20) & 0xFu; }
#define XB_SPIN(cond, bar) do { unsigned _sp = 0; while (cond) { __builtin_amdgcn_s_sleep(1); \
    if ((++_sp & 255u) == 0u) { if (xb_ld(&(bar)[XB_TMO])) break; if (_sp > XB_SPIN_CAP) { atomicAdd(&(bar)[XB_TMO], 1u); break; } } } } while (0)

struct XcdBarrier {
    unsigned* bar; unsigned x;
    volatile LAS unsigned* st;
};

__device__ __forceinline__ XcdBarrier xcd_barrier_post(unsigned* bar, volatile LAS unsigned* st) {
    XcdBarrier b; b.bar = bar; b.x = xb_xcc_id(); b.st = st;
    if (threadIdx.x == 0) (void)xb_add(&bar[XB_XCNT(b.x)], 1u);
    return b;
}
__device__ __forceinline__ void xcd_barrier_complete(unsigned* bar, unsigned x, unsigned& nloc, unsigned& nx) {
    const unsigned G = gridDim.x * gridDim.y * gridDim.z;
    unsigned sum, cnt, mine, sp = 0u;
    for (;;) {
        sum = 0u; cnt = 0u; mine = 0u;
#pragma unroll
        for (unsigned j = 0; j < 16; ++j) { const unsigned c = xb_ld(&bar[XB_XCNT(j)]); sum += c; cnt += (c > 0u) ? 1u : 0u; mine = (j == x) ? c : mine; }
        if (sum == G) break;
        __builtin_amdgcn_s_sleep(1);
        if ((++sp & 255u) == 0u) { if (xb_ld(&bar[XB_TMO])) break; if (sp > XB_SPIN_CAP) { atomicAdd(&bar[XB_TMO], 1u); break; } }
    }
    nloc = mine > 0u ? mine : 1u; nx = cnt > 0u ? cnt : 1u;
}

__device__ __forceinline__ void xcd_barrier(const XcdBarrier& b) {
    asm volatile("s_waitcnt vmcnt(0)" ::: "memory");
    __syncthreads();
    if (threadIdx.x == 0) {
        unsigned* bar = b.bar;
        __builtin_amdgcn_s_waitcnt(0);
        unsigned nloc = b.st[0], nx = b.st[1];
        if (nloc == 0u) { xcd_barrier_complete(bar, b.x, nloc, nx); b.st[0] = nloc; b.st[1] = nx; }
        const unsigned old = xb_add(&bar[XB_XSUB(b.x)], 1u);
        const unsigned gen = old / nloc;
        if (old + 1u == (gen + 1u) * nloc) {
            __builtin_amdgcn_fence(__ATOMIC_RELEASE, "agent");
            asm volatile("s_waitcnt vmcnt(0)" ::: "memory");
            const unsigned og = xb_add(&bar[XB_TOP], 1u);
            const unsigned tg = og / nx;
            if (og + 1u == (tg + 1u) * nx) xb_add(&bar[XB_TOPGEN], 1u);
            else XB_SPIN(xb_ld(&bar[XB_TOPGEN]) == tg, bar);
            __builtin_amdgcn_fence(__ATOMIC_ACQUIRE, "agent");
            xb_add(&bar[XB_XGEN(b.x)], 1u);
            asm volatile("s_waitcnt vmcnt(0)" ::: "memory");
        } else {
            XB_SPIN(xb_ld(&bar[XB_XGEN(b.x)]) == gen, bar);
            __builtin_amdgcn_fence(__ATOMIC_ACQUIRE, "agent");
            asm volatile("s_waitcnt vmcnt(0)" ::: "memory");
        }
    }
    __syncthreads();
}

__device__ __forceinline__ int inv32(int j) { return 16 * ((j >> 2) & 1) + 4 * (j >> 3) + (j & 3); }
struct DestEvenIn { __device__ __forceinline__ int operator()(int n) const {
    if (n < 8192) { const int seg = n >> 11, ch = n & 2047, t = ch >> 6, ci = ch & 63; return 256 * t + 128 * (seg >> 1) + 32 * (ci >> 4) + 16 * (seg & 1) + (ci & 15); }
    if (n < 9216) return (n & ~31) + inv32(n & 31);
    if (n < 9280) return n;
    const int m = n - 9280; return 9472 + (m & ~31) + inv32(m & 31); } };
struct DestQb { __device__ __forceinline__ int operator()(int n) const { const int h = n / 192, j = n - 192 * h; return j < 128 ? 192 * h + (j & ~31) + inv32(j & 31) : n; } };
struct DestP32 { __device__ __forceinline__ int operator()(int n) const { return (n & ~31) + inv32(n & 31); } };
struct DestId { __device__ __forceinline__ int operator()(int n) const { return n; } };
struct DestOddIn { __device__ __forceinline__ int operator()(int n) const {
    if (n < 4096) return 256 * (n >> 7) + ((n & 127) & ~31) + inv32(n & 31);
    if (n < 8192) { const int ch = n - 4096; return 8192 + (ch & ~31) + inv32(ch & 31); }
    const int ch = n - 8192; return 256 * (ch >> 7) + 128 + ((ch & 127) & ~31) + inv32(ch & 31); } };
template <class DestFn> __device__ __forceinline__ void cvt_item(const float* __restrict__ W, int K, int N, bf16* __restrict__ WT, const DestFn& dest, const float* __restrict__ kscale, LAS float* scr, int item, int lane) {
    const int nblk = N / 32, kb = item / nblk, nb = item - kb * nblk, k0 = 64 * kb, n0 = 32 * nb;
    f32x4 v[8];
#pragma unroll
    for (int i = 0; i < 8; ++i) v[i] = *(const f32x4*)(W + (size_t)(k0 + 8 * i + (lane >> 3)) * N + n0 + 4 * (lane & 7));
#pragma unroll
    for (int i = 0; i < 8; ++i) { const int kk = 8 * i + (lane >> 3); f32x4 x = v[i]; if (kscale) x = x * kscale[k0 + kk]; LAS float* p = scr + kk * 33 + 4 * (lane & 7); p[0] = x.x; p[1] = x.y; p[2] = x.z; p[3] = x.w; }
    LDS_WAIT(); asm volatile("" ::: "memory");
    const int c = lane & 7;
#pragma unroll
    for (int j = 0; j < 4; ++j) { const int n = (lane >> 3) + 8 * j; const LAS float* s = scr + (8 * c) * 33 + n;
        v4u o; o.x = cvt_pk_bf16(s[0 * 33], s[1 * 33]); o.y = cvt_pk_bf16(s[2 * 33], s[3 * 33]); o.z = cvt_pk_bf16(s[4 * 33], s[5 * 33]); o.w = cvt_pk_bf16(s[6 * 33], s[7 * 33]);
        *(v4u*)(WT + (size_t)dest(n0 + n) * K + k0 + 8 * c) = o; }
    LDS_WAIT(); asm volatile("" ::: "memory");
}
__device__ __forceinline__ void modnorm_rows(const float* __restrict__ xp, const float* __restrict__ xs, const float* __restrict__ xo, int first, const float* __restrict__ g, const float* __restrict__ mod  ,
                                             bf16* __restrict__ H, int gw, int ngw, int lane) {
    for (int rb = gw; rb < MT; rb += 2 * ngw) {
        f32x4 v[2][8];
#pragma unroll
        for (int t = 0; t < 2; ++t) { const int row = rb + t * ngw < MT ? rb + t * ngw : rb;
            const float* xr = first ? (row < NPR ? xp + (size_t)row * DM : xs + (size_t)(row - NPR) * DM) : xo + (size_t)row * DM;
#pragma unroll
            for (int j = 0; j < 8; ++j) v[t][j] = *(const f32x4*)(xr + 4 * lane + 256 * j); }
#pragma unroll
        for (int t = 0; t < 2; ++t) { const int row = rb + t * ngw; if (row >= MT) break;
            const int cr = row < NPR ? 0 : 1 + ((row - NPR) >> 12);
            const float* md = mod + (size_t)cr * 6144; float ss = 0.f;
#pragma unroll
            for (int j = 0; j < 8; ++j) ss += (v[t][j].x * v[t][j].x + v[t][j].y * v[t][j].y) + (v[t][j].z * v[t][j].z + v[t][j].w * v[t][j].w);
            const float rstd = __builtin_amdgcn_rsqf(wave_sum(ss) * (1.f / DM) + EPS);
#pragma unroll
            for (int j = 0; j < 8; ++j) { const int c = 4 * lane + 256 * j; const f32x4 gg = *(const f32x4*)(g + c), sh = *(const f32x4*)(md + c), sc = *(const f32x4*)(md + 2048 + c);
                *(v2u*)(H + (size_t)row * DM + c) = pack4(v[t][j] * rstd * gg * (sc + 1.f) + sh); } }
    }
}
__device__ __forceinline__ void modnorm_rows_bf(const bf16* __restrict__ xb, const float* __restrict__ g, const float* __restrict__ mod  , bf16* __restrict__ H, int gw, int ngw, int lane) {
    for (int rb = gw; rb < MT; rb += 2 * ngw) {
        v4u v[2][4];
#pragma unroll
        for (int t = 0; t < 2; ++t) { const int row = rb + t * ngw < MT ? rb + t * ngw : rb;
#pragma unroll
            for (int j = 0; j < 4; ++j) v[t][j] = *(const v4u*)(xb + (size_t)row * DM + 8 * lane + 512 * j); }
#pragma unroll
        for (int t = 0; t < 2; ++t) { const int row = rb + t * ngw; if (row >= MT) break;
            const int cr = row < NPR ? 0 : 1 + ((row - NPR) >> 12);
            const float* md = mod + (size_t)cr * 6144; float ss = 0.f; f32x4 xa[4], xc[4];
#pragma unroll
            for (int j = 0; j < 4; ++j) { xa[j] = unp_lo(v[t][j]); xc[j] = unp_hi(v[t][j]);
                ss += (xa[j].x * xa[j].x + xa[j].y * xa[j].y) + (xa[j].z * xa[j].z + xa[j].w * xa[j].w) + (xc[j].x * xc[j].x + xc[j].y * xc[j].y) + (xc[j].z * xc[j].z + xc[j].w * xc[j].w); }
            const float rstd = __builtin_amdgcn_rsqf(wave_sum(ss) * (1.f / DM) + EPS);
#pragma unroll
            for (int j = 0; j < 4; ++j) { const int c = 8 * lane + 512 * j;
                const f32x4 g0 = *(const f32x4*)(g + c), g1 = *(const f32x4*)(g + c + 4), s0 = *(const f32x4*)(md + c), s1 = *(const f32x4*)(md + c + 4), c0 = *(const f32x4*)(md + 2048 + c), c1 = *(const f32x4*)(md + 2048 + c + 4);
                *(v4u*)(H + (size_t)row * DM + c) = pack8(xa[j] * rstd * g0 * (c0 + 1.f) + s0, xc[j] * rstd * g1 * (c1 + 1.f) + s1); } }
    }
}
__device__ __forceinline__ void adaln_item(LAS unsigned char* lds, const float* __restrict__ c, const float* __restrict__ c_ctx, const float* __restrict__ w_ada, const float* __restrict__ b_ada, float* __restrict__ MOD, int item, int tid) {
    LAS float* sc = (LAS float*)lds;
#pragma unroll 6
    for (int i = tid; i < 9 * 2048; i += 512) { const int r = i >> 11, k = i & 2047; sc[i] = silu_f(r == 0 ? c_ctx[k] : c[(r - 1) * 2048 + k]); }
    __syncthreads();
    const int l = item / 24, cb = item - 24 * l, lane = tid & 63, w = tid >> 6;
    const float* W = w_ada + ((size_t)l * 2048 + w * 256) * 6144 + cb * 256 + lane * 4;
    f32x4 acc[9];
#pragma unroll
    for (int r = 0; r < 9; ++r) acc[r] = (f32x4){0.f, 0.f, 0.f, 0.f};
#pragma unroll 4
    for (int k = 0; k < 256; k += 4) {
        const f32x4 w0 = *(const f32x4*)(W + (size_t)(k + 0) * 6144), w1 = *(const f32x4*)(W + (size_t)(k + 1) * 6144), w2 = *(const f32x4*)(W + (size_t)(k + 2) * 6144), w3 = *(const f32x4*)(W + (size_t)(k + 3) * 6144);
#pragma unroll
        for (int r = 0; r < 9; ++r) { const f32x4 s = *(const LAS f32x4*)(sc + r * 2048 + w * 256 + k); acc[r] += w0 * s.x + w1 * s.y + w2 * s.z + w3 * s.w; }
    }
    __syncthreads();
    LAS float* red = (LAS float*)lds;
#pragma unroll
    for (int r = 0; r < 9; ++r) *(LAS f32x4*)(red + (w * 9 + r) * 256 + lane * 4) = acc[r];
    __syncthreads();
    for (int o = tid; o < 9 * 256; o += 512) { const int r = o >> 8, cc = o & 255; float s = b_ada[l * 6144 + cb * 256 + cc];
#pragma unroll
        for (int w2 = 0; w2 < 8; ++w2) s += red[(w2 * 9 + r) * 256 + cc];
        MOD[(size_t)(l * 9 + r) * 6144 + cb * 256 + cc] = s; }
    __syncthreads();
}
__device__ const double ROPE_CT[16] = {0.5403023058681398, 0.8460091102817079, 0.9504152802551828, 0.9842302344700946, 0.9950041652780258, 0.9984192777926645, 0.9995000416652778, 0.9998418902836144,
                                       0.9999500004166653, 0.9999841886533658, 0.9999950000041666, 0.9999984188615866, 0.9999995000000417, 0.9999998418861211, 0.9999999500000004, 0.9999999841886117};
__device__ const double ROPE_ST[16] = {0.8414709848078965, 0.5331684399140229, 0.31098359290718575, 0.17689218624615005, 0.09983341664682814, 0.056204499214692484, 0.03161750640243371, 0.01778185687966613,
                                       0.009999833334166664, 0.005623383613960186, 0.0031622723897082477, 0.0017782784728035289, 0.0009999998333333417, 0.0005623412955523593, 0.0003162277607463752, 0.00017782794006665676};
__device__ __forceinline__ void e3_norm_rows(const bf16* __restrict__ QA, const bf16* __restrict__ CKVR, const float* __restrict__ kvg, bf16* __restrict__ QN, bf16* __restrict__ CKV, float* __restrict__ nckv  ,
                                             int gw, int ngw, int lane) {
    const f32x4 g0 = *(const f32x4*)(kvg + 8 * lane), g1 = *(const f32x4*)(kvg + 8 * lane + 4);
    for (int rb = gw; rb < MT; rb += 4 * ngw) {
        v4u wq[4], wc[4];
#pragma unroll
        for (int t = 0; t < 4; ++t) { const int row = rb + t * ngw; if (row < MT) { wq[t] = *(const v4u*)(QA + (size_t)row * 512 + 8 * lane); wc[t] = *(const v4u*)(CKVR + (size_t)row * 512 + 8 * lane); } else { wq[t] = zero4(); wc[t] = wq[t]; } }
#pragma unroll
        for (int t = 0; t < 4; ++t) { const int row = rb + t * ngw; if (row >= MT) break;
            { const f32x4 a = unp_lo(wq[t]), b = unp_hi(wq[t]); const float ss = (a.x * a.x + a.y * a.y) + (a.z * a.z + a.w * a.w) + (b.x * b.x + b.y * b.y) + (b.z * b.z + b.w * b.w);
              const float rstd = __builtin_amdgcn_rsqf(wave_sum(ss) * (1.f / 512.f) + EPS);
              *(v4u*)(QN + (size_t)row * 512 + 8 * lane) = pack8(a * rstd, b * rstd); }
            { const f32x4 a = unp_lo(wc[t]), b = unp_hi(wc[t]); const float ss = (a.x * a.x + a.y * a.y) + (a.z * a.z + a.w * a.w) + (b.x * b.x + b.y * b.y) + (b.z * b.z + b.w * b.w);
              const float rstd = __builtin_amdgcn_rsqf(wave_sum(ss) * (1.f / 512.f) + EPS);
              const f32x4 y0 = a * rstd * g0, y1 = b * rstd * g1;
              *(v4u*)(CKV + (size_t)pg8::kvrow_of(row) * 512 + 8 * lane) = pack8(y0, y1);
              if (row < NPR) { float* op = nckv + (size_t)(row >> 8) * (2 * 256 * 512) + (row & 255) * 512 + 8 * lane; *(f32x4*)op = y0; *(f32x4*)(op + 4) = y1; } } }
    }
}
__device__ __forceinline__ void e3_cache_rows(const float* __restrict__ cckv  , const float* __restrict__ ckpe  ,
                                              bf16* __restrict__ CKV, bf16* __restrict__ KPE, int gw, int ngw, int lane) {
    for (int r = gw; r < 8 * 512; r += ngw) { const int b = r >> 9, j = r & 511; const size_t kvr = (size_t)NPR + (size_t)b * KVS + j;
        const float* sp = cckv + (size_t)b * (2 * 512 * 512) + (size_t)j * 512 + 8 * lane;
        *(v4u*)(CKV + kvr * 512 + 8 * lane) = pack8(*(const f32x4*)sp, *(const f32x4*)(sp + 4));
        if (lane < 8) { const float* kp = ckpe + (size_t)b * (2 * 512 * 64) + (size_t)j * 64 + 8 * lane; *(v4u*)(KPE + kvr * 64 + 8 * lane) = pack8(*(const f32x4*)kp, *(const f32x4*)(kp + 4)); } }
}
__device__ __forceinline__ void e3_conv_fix(const bf16* __restrict__ U1B, const bf16* __restrict__ PPB, const float* __restrict__ cw  , bf16* __restrict__ MIX, int gw, int ngw, int lane) {
    for (int k = gw; k < MT / 8; k += ngw) { const int g = k >> 1, top = k & 1, row = 16 * g + (top ? 15 : 0);
        const bool hp = row < NPR ? (row & 255) != 0 : ((row - NPR) & 4095) != 0, hn = row < NPR ? (row & 255) != 255 : ((row - NPR) & 4095) != 4095;
        const bf16* pu_ = U1B + (size_t)k * 2048; const bf16* p1_ = PPB + ((size_t)g * 4 + (top ? 3 : 0)) * 2048;
        const bf16* p0_ = top ? PPB + ((size_t)g * 4 + 2) * 2048 : PPB + ((size_t)(g - 1) * 4 + 3) * 2048;
        const bf16* p2_ = top ? PPB + ((size_t)(g + 1) * 4 + 0) * 2048 : PPB + ((size_t)g * 4 + 1) * 2048;
        const bool l0 = top || hp, l2 = !top || hn;
#pragma unroll
        for (int it = 0; it < 4; ++it) { const int c = 8 * lane + 512 * it;
            const v4u pu = *(const v4u*)(pu_ + c), p1 = *(const v4u*)(p1_ + c); v4u p0 = zero4(), p2 = zero4();
            if (l0) p0 = *(const v4u*)(p0_ + c); if (l2) p2 = *(const v4u*)(p2_ + c);
            const f32x4 w0a = *(const f32x4*)(cw + c), w0b = *(const f32x4*)(cw + c + 4), w1a = *(const f32x4*)(cw + 2048 + c), w1b = *(const f32x4*)(cw + 2048 + c + 4), w2a = *(const f32x4*)(cw + 4096 + c), w2b = *(const f32x4*)(cw + 4096 + c + 4);
            const f32x4 ya = unp_lo(pu) * (w0a * unp_lo(p0) + w1a * unp_lo(p1) + w2a * unp_lo(p2)), yb = unp_hi(pu) * (w0b * unp_hi(p0) + w1b * unp_hi(p1) + w2b * unp_hi(p2));
            *(v4u*)(MIX + (size_t)row * 4096 + c) = pack8(ya, yb); }
    }
}
__device__ __forceinline__ void final_rows(const bf16* __restrict__ xb, float* __restrict__ xo, const float* __restrict__ g, int gw, int ngw, int lane) {
    for (int rb = gw; rb < MT; rb += 2 * ngw) { v4u v[2][4];
#pragma unroll
        for (int t = 0; t < 2; ++t) { const int row = rb + t * ngw < MT ? rb + t * ngw : rb;
#pragma unroll
            for (int j = 0; j < 4; ++j) v[t][j] = *(const v4u*)(xb + (size_t)row * DM + 8 * lane + 512 * j); }
#pragma unroll
        for (int t = 0; t < 2; ++t) { const int row = rb + t * ngw; if (row >= MT) break; float* xr = xo + (size_t)row * DM; float ss = 0.f; f32x4 xa[4], xc[4];
#pragma unroll
            for (int j = 0; j < 4; ++j) { xa[j] = unp_lo(v[t][j]); xc[j] = unp_hi(v[t][j]);
                ss += (xa[j].x * xa[j].x + xa[j].y * xa[j].y) + (xa[j].z * xa[j].z + xa[j].w * xa[j].w) + (xc[j].x * xc[j].x + xc[j].y * xc[j].y) + (xc[j].z * xc[j].z + xc[j].w * xc[j].w); }
            const float rstd = __builtin_amdgcn_rsqf(wave_sum(ss) * (1.f / DM) + EPS);
#pragma unroll
            for (int j = 0; j < 4; ++j) { const int c = 8 * lane + 512 * j; *(f32x4*)(xr + c) = xa[j] * rstd * *(const f32x4*)(g + c); *(f32x4*)(xr + c + 4) = xc[j] * rstd * *(const f32x4*)(g + c + 4); } } }
}
__device__ __forceinline__ void sg_phase(LAS unsigned char* lds, int vcu, int G, const bf16* __restrict__ VR, const float* __restrict__ stats, const float* __restrict__ lng, const float* __restrict__ lnb,
                                         const bf16* __restrict__ WsB  , const float* __restrict__ bs  , bf16* __restrict__ UG) {
    int tid_ = threadIdx.x; asm volatile("" : "+v"(tid_));
    const int tid = tid_, wid = __builtin_amdgcn_readfirstlane(tid >> 6), lane = tid & 63, r32 = lane & 31, hi = lane >> 5;
    constexpr int NUNITS = 288 * 8;
    if (vcu >= NUNITS) return;
    const int nU = (NUNITS - vcu + G - 1) / G, nS = 2 * nU;
    LAS f32x2* ST = (LAS f32x2*)(lds + 65536);
    for (int r = tid; r < nU * 128; r += 512) { const int c = (vcu + (r >> 7) * G) >> 3; const f32x4* sp = (const f32x4*)(stats + (size_t)(c * 128 + (r & 127)) * 128); float s = 0.f, q = 0.f;
#pragma unroll 16
        for (int k = 0; k < 32; ++k) { const f32x4 v = sp[k]; s += v.x + v.z; q += v.y + v.w; }
        const float mean = s * (1.f / 4096.f), var = q * (1.f / 4096.f) - mean * mean; ST[r] = (f32x2){mean, __builtin_amdgcn_rsqf(var + EPS)}; }
    const int pb = wid & 3, dh = wid >> 2, q0 = tid >> 5, d = 8 * (tid & 31);
    v4u vr[8];
#define SG_LOAD_VR(s_) do { const int sn_ = (s_), un_ = vcu + (sn_ >> 1) * G; const bf16* vp_ = VR + (size_t)((un_ >> 3) * 128 + q0) * 4096 + (2 * (un_ & 7) + (sn_ & 1)) * 256 + d; \
        _Pragma("unroll") for (int k = 0; k < 8; ++k) vr[k] = *(const v4u*)(vp_ + (size_t)k * 16 * 4096); } while (0)
    SG_LOAD_VR(0);
    __syncthreads();
    for (int s = 0; s < nS; ++s) {
        const int u = vcu + (s >> 1) * G, c = u >> 3, g = 2 * (u & 7) + (s & 1), r0 = 128 * c;
        { const float* gp = lng + g * 256 + d; const float* bp = lnb + g * 256 + d; const f32x4 ga = *(const f32x4*)gp, gb = *(const f32x4*)(gp + 4), ba = *(const f32x4*)bp, bb = *(const f32x4*)(bp + 4);
#pragma unroll
          for (int k = 0; k < 8; ++k) { const int q = q0 + 16 * k; const f32x2 st = ST[(s >> 1) * 128 + q]; const v4u w = vr[k];
            const f32x4 ya = (unp_lo(w) - st.x) * st.y * ga + ba, yb = (unp_hi(w) - st.x) * st.y * gb + bb;
            *(LAS v4u*)(lds + ((q >> 6) * 2 + (d >> 7)) * 16384 + att::v_st(q & 63, d & 127)) = pack8(ya, yb); } }
        v4u ug[8]; bf16* up = UG + (size_t)(r0 + q0) * 4096 + g * 256 + d;
#pragma unroll
        for (int k = 0; k < 8; ++k) ug[k] = *(const v4u*)(up + (size_t)k * 16 * 4096);
        if (s + 1 < nS) SG_LOAD_VR(s + 1);
        bf16x8 afr[8];
        { const bf16* ap = WsB + ((size_t)(g * 128 + 32 * pb + r32)) * 128 + 8 * hi;
#pragma unroll
          for (int t = 0; t < 8; ++t) afr[t] = *(const bf16x8*)(ap + 16 * t); }
        float bsv[16];
#pragma unroll
        for (int r = 0; r < 16; ++r) bsv[r] = bs[g * 128 + 32 * pb + att::crow(r, hi)];
        __syncthreads();
        f32x16 od[4] = {};
#pragma unroll
        for (int qh = 0; qh < 2; ++qh) { const int vb = (int)(unsigned)(uintptr_t)(lds + (qh * 2 + dh) * 16384) + att::v_rd_base(lane);
            att::pv_d0(od, vb, afr[4 * qh + 0], afr[4 * qh + 1], afr[4 * qh + 2], afr[4 * qh + 3]); }
        __syncthreads();
#pragma unroll
        for (int r = 0; r < 16; ++r) { const int p = 32 * pb + att::crow(r, hi);
#pragma unroll
            for (int d0 = 0; d0 < 4; ++d0) *(LAS bf16*)(lds + p * 512 + (dh * 128 + d0 * 32 + r32) * 2) = (bf16)(cvt_pk_bf16(od[d0][r] + bsv[r], 0.f) & 0xffffu); }
        __syncthreads();
#pragma unroll
        for (int k = 0; k < 8; ++k) { const v4u a = *(const LAS v4u*)(lds + (q0 + 16 * k) * 512 + 2 * d), w = ug[k];
            v4u o; o.x = cvt_pk_bf16(bflo(a.x) * bflo(w.x), bfhi(a.x) * bfhi(w.x)); o.y = cvt_pk_bf16(bflo(a.y) * bflo(w.y), bfhi(a.y) * bfhi(w.y));
            o.z = cvt_pk_bf16(bflo(a.z) * bflo(w.z), bfhi(a.z) * bfhi(w.z)); o.w = cvt_pk_bf16(bflo(a.w) * bflo(w.w), bfhi(a.w) * bfhi(w.w));
            *(v4u*)(up + (size_t)k * 16 * 4096) = o; }
        __syncthreads();
    }
#undef SG_LOAD_VR
}

__device__ __forceinline__ void convert_even(const float* w_in, const float* w_qb, const float* w_kvb, const float* w_out, const float* qg, bf16* WEIN, bf16* WEQB, bf16* WEKVB, bf16* WEOUT, LAS float* scr, int w, int nw, int lane) {
    constexpr int I_IN = 32 * (EVEN_IN / 32), I_QB = 8 * 96, I_KVB = 8 * 128, I_OUT = 64 * 64;
    for (int it = w; it < I_IN + I_QB + I_KVB + I_OUT; it += nw) { int r = it;
        if (r < I_IN) { cvt_item(w_in, 2048, EVEN_IN, WEIN, DestEvenIn{}, (const float*)nullptr, scr, r, lane); continue; } r -= I_IN;
        if (r < I_QB) { cvt_item(w_qb, 512, 3072, WEQB, DestQb{}, qg, scr, r, lane); continue; } r -= I_QB;
        if (r < I_KVB) { cvt_item(w_kvb, 512, 4096, WEKVB, DestP32{}, (const float*)nullptr, scr, r, lane); continue; } r -= I_KVB;
        cvt_item(w_out, 4096, 2048, WEOUT, DestP32{}, (const float*)nullptr, scr, r, lane); }
    for (int q = w * 64 + lane; q < 192 * 2048 / 8; q += nw * 64) *(v4u*)(WEIN + (size_t)9280 * 2048 + (size_t)q * 8) = zero4();
}
__device__ __forceinline__ void convert_odd(const float* w_in, const float* w_out, const float* wsrc, bf16* WOIN, bf16* WOOUT, bf16* WOS, LAS float* scr, int w, int nw, int lane) {
    constexpr int I_IN = 32 * (ODD_IN / 32), I_OUT = 64 * 64;
    for (int it = w; it < I_IN + I_OUT; it += nw) { int r = it;
        if (r < I_IN) { cvt_item(w_in, 2048, ODD_IN, WOIN, DestOddIn{}, (const float*)nullptr, scr, r, lane); continue; } r -= I_IN;
        cvt_item(w_out, 4096, 2048, WOOUT, DestP32{}, (const float*)nullptr, scr, r, lane); }
    for (int q = w * 64 + lane; q < 16 * 128 * 128 / 8; q += nw * 64) *(v4u*)(WOS + (size_t)q * 8) = pack8(*(const f32x4*)(wsrc + (size_t)q * 8), *(const f32x4*)(wsrc + (size_t)q * 8 + 4));
}

constexpr int NPH = 26;
#ifndef MK_N_LAUNCHES
#define MK_N_LAUNCHES 1
#endif
struct Args { const float* in[23]; float* out; unsigned char* ws; int ph_lo, ph_hi; };
__global__ void __launch_bounds__(512, 2) fwd(Args args) {
    extern __shared__ __attribute__((aligned(16))) unsigned char lds_raw[];
    LAS unsigned char* lds = (LAS unsigned char*)lds_raw;
    volatile LAS unsigned* MISC = (volatile LAS unsigned*)(lds + MISC_OFF);
    const int tid0 = threadIdx.x, lane0 = tid0 & 63, wave = __builtin_amdgcn_readfirstlane(tid0 >> 6);
    const int G0 = gridDim.x, bx0 = blockIdx.x, vcu0 = (G0 % 8 == 0) ? (bx0 % 8) * (G0 / 8) + bx0 / 8 : bx0;
    for (int u = tid0; u < (LDS_BYTES - LDSCTL_OFF) / 4; u += 512) ((LAS unsigned*)(lds + LDSCTL_OFF))[u] = 0u;
    __syncthreads();
    XcdBarrier bar = xcd_barrier_post((unsigned*)(args.ws + WS_CTL) + CW_BAR, MISC + 8);
    const int lo = args.ph_lo, hi = args.ph_hi; (void)lo; (void)hi;
#ifndef PH_MASK
#define PH_MASK 0xFFFF
#endif
#define EN(b) (((PH_MASK) >> (b)) & 1)
#ifndef PROBE_DUP
#define PROBE_DUP 0
#endif
#define REPS(b) for (int rep_ = 0; rep_ < ((((PROBE_DUP) >> (b)) & 1) ? 2 : 1); ++rep_)
#if MK_N_LAUNCHES == 1
#define IN(k) true
#else
#define IN(k) (lo <= (k) && (k) < hi)
#endif
#define SEAM(k) do { if (IN((k) + 1)) { XcdBarrier b_ = bar; asm volatile("" : "+s"(b_.bar), "+s"(b_.x)); xcd_barrier(b_); } } while (0)
#define PHASE_Z() int z_ = 0; asm volatile("; phase" : "+s"(z_)); unsigned char* ws = args.ws + z_; int lane = lane0; asm volatile("" : "+v"(lane)); const int tid = wave * 64 + lane; \
    int G = G0, bx = bx0, vcu = vcu0; asm volatile("" : "+s"(G), "+s"(bx), "+s"(vcu)); const int gw = vcu * 8 + wave, ngw = G * 8; (void)tid; (void)gw; (void)ngw; (void)bx
#define INP(k) (args.in[(k) + z_])
#define XO ((float*)args.out + z_)
#define NEW_CKV (XO + (size_t)MT * DM)
#define NEW_KPE (NEW_CKV + (size_t)16 * 2 * 256 * 512)
#define MOD ((float*)(ws + WS_MOD))
#define ROPE ((float*)(ws + WS_ROPE))
#define WSP(off) ((bf16*)(ws + (off)))
#define CONVERT_EVEN(ii, w_, nw_) convert_even(INP(9) + (size_t)(ii) * 2048 * EVEN_IN, INP(12) + (size_t)(ii) * 512 * 3072, INP(14) + (size_t)(ii) * 512 * 4096, INP(15) + (size_t)(ii) * 4096 * 2048, INP(11) + (ii) * 512, \
        WSP(WE_IN), WSP(WE_QB), WSP(WE_KVB), WSP(WE_OUT), scr, (w_), (nw_), lane)
#define CONVERT_ODD(ii, w_, nw_) convert_odd(INP(16) + (size_t)(ii) * 2048 * ODD_IN, INP(21) + (size_t)(ii) * 4096 * 2048, INP(19) + (size_t)(ii) * 16 * 128 * 128, WSP(WO_IN), WSP(WO_OUT), WSP(WO_S), scr, (w_), (nw_), lane)
#define TAIL_WORKERS() const int R_ = 1152 % G, cw_ = R_ ? bx - R_ : bx, ncw_ = R_ ? G - R_ : G
    LAS float* scr = (LAS float*)(lds + wave * 16384);

    if (EN(0) && IN(0)) { PHASE_Z();
        for (int it = bx; it < 96; it += G) adaln_item(lds, INP(4), INP(5), INP(7), INP(8), MOD, it, tid);
        { const int cw_ = G > 96 ? bx - 96 : bx, ncw_ = G > 96 ? G - 96 : G; if (cw_ >= 0) CONVERT_EVEN(0, cw_ * 8 + wave, ncw_ * 8); }
        if (bx == G - 1 && tid < 16) { const double ct = ROPE_CT[tid], st = ROPE_ST[tid]; double cc = 1.0, ss = 0.0; float* rope = ROPE;
            for (int pos = 0; pos < 64; ++pos) { rope[(pos * 16 + tid) * 2] = (float)cc; rope[(pos * 16 + tid) * 2 + 1] = (float)ss; const double nc = cc * ct - ss * st; ss = ss * ct + cc * st; cc = nc; } }
        SEAM(0);
    }
    for (int lp = 0; lp < 2; ++lp) {
        const int pb = 1 + 12 * lp, i = lp;
        { const int l = 2 * lp;
        if (EN(1) && IN(pb + 0)) { PHASE_Z();
            REPS(1) {
            if (l == 0) modnorm_rows(INP(0), INP(1), XO, 1, INP(6) + (size_t)l * DM, MOD + (size_t)l * 9 * 6144, WSP(WS_HE), gw, ngw, lane);
            else modnorm_rows_bf(WSP(WS_XB), INP(6) + (size_t)l * DM, MOD + (size_t)l * 9 * 6144, WSP(WS_HE), gw, ngw, lane);
            }
            SEAM(pb + 0);
        }
        if (EN(2) && IN(pb + 1)) { PHASE_Z();
            REPS(2) {
            pg8::Gemm g{WSP(WS_HE), WSP(WE_IN), MT, EVEN_NV, 2048}; pg8::StaticOrder S; S.init(MT, EVEN_NV, G, bx);
            pg8::EpiEvenIn E{WSP(WS_MIX), WSP(WS_PPB), WSP(WS_U1B), WSP(WS_QA), WSP(WS_CKVR), WSP(WS_KPE), NEW_KPE + (size_t)i * 256 * 64, ROPE, INP(10) + (size_t)i * 3 * 2048};
            pg8::gemm_phase<pg8::EpiEvenIn, pg8::StaticOrder, true, true>(lds, g, S, E);
            }
            SEAM(pb + 1);
        }
        if (EN(3) && IN(pb + 2)) { PHASE_Z();
            REPS(3) {
            e3_norm_rows(WSP(WS_QA), WSP(WS_CKVR), INP(13) + i * 512, WSP(WS_QN), WSP(WS_CKV), NEW_CKV + (size_t)i * 256 * 512, gw, ngw, lane);
            e3_cache_rows(INP(2) + (size_t)i * 512 * 512, INP(3) + (size_t)i * 512 * 64, WSP(WS_CKV), WSP(WS_KPE), gw, ngw, lane);
            e3_conv_fix(WSP(WS_U1B), WSP(WS_PPB), INP(10) + (size_t)i * 3 * 2048, WSP(WS_MIX), gw, ngw, lane);
            }
            SEAM(pb + 2);
        }
        for (int hg = 0; hg < 2; ++hg) {
            if (EN(4) && IN(pb + 3 + 2 * hg)) { PHASE_Z();
            REPS(4) {
                { pg8::Gemm g{WSP(WS_QN), WSP(WE_QB) + (size_t)hg * 1536 * 512, MT, 1536, 512}; pg8::StaticOrder S; S.init(MT, 1536, G, bx); pg8::EpiQ E{WSP(WS_Q), ROPE};
                  pg8::gemm_phase<pg8::EpiQ, pg8::StaticOrder, true, true>(lds, g, S, E); }
                { pg8::Gemm g{WSP(WS_CKV), WSP(WE_KVB) + (size_t)hg * 2048 * 512, KVR, 2048, 512}; pg8::StaticOrder S; S.init(KVR, 2048, G, bx); pg8::EpiStore E{WSP(WS_KV), 2048};
                  pg8::gemm_phase<pg8::EpiStore, pg8::StaticOrder, true, true>(lds, g, S, E); }
            }
                SEAM(pb + 3 + 2 * hg);
            }
            if (EN(5) && IN(pb + 4 + 2 * hg)) { PHASE_Z();
            REPS(5) {
                const bf16* Qb = WSP(WS_Q); const unsigned char* KVb = ws + WS_KV; const unsigned char* KPEb = ws + WS_KPE; bf16* MIX = WSP(WS_MIX);
                for (int u = vcu; u < 1152; u += G) {
                    int b, hl, qrow0, kvrow0, NT;
                    if (u < 1024) { b = u >> 7; hl = (u >> 4) & 7; qrow0 = NPR + b * 4096 + (u & 15) * 256; kvrow0 = NPR + b * KVS; NT = 72; }
                    else { const int v = u - 1024; b = v >> 3; hl = v & 7; qrow0 = b * 256; kvrow0 = b * 256; NT = 4; }
                    const int h = hg * 8 + hl; const unsigned char* kvp = KVb + ((size_t)kvrow0 * 2048 + hl * 256) * 2;
                    att::unit(lds, Qb + (size_t)qrow0 * 1536 + hl * 192, 1536, kvp, kvp + 256, KPEb + (size_t)kvrow0 * 128, NT,
                              MIX + (size_t)qrow0 * 4096 + 2048 + h * 128, 4096, MIX + (size_t)qrow0 * 4096 + 2048 + h * 128, 4096);
                }
            }
                SEAM(pb + 4 + 2 * hg);
            }
        }
        if (EN(6) && IN(pb + 7)) { PHASE_Z();
            pg8::Gemm g{WSP(WS_MIX), WSP(WE_OUT), MT, 2048, 4096}; pg8::StaticOrder S; S.init(MT, 2048, G, bx);
            pg8::EpiResid E{INP(0), INP(1), WSP(WS_XB), XO, MOD + (size_t)l * 9 * 6144 + 4096, l == 0 ? 1 : 0, 0};
            pg8::gemm_phase<pg8::EpiResid, pg8::StaticOrder, true, true>(lds, g, S, E);
            { TAIL_WORKERS(); if (cw_ >= 0) CONVERT_ODD(i, cw_ * 8 + wave, ncw_ * 8); }
            SEAM(pb + 7);
        }
        }
        { const int l = 2 * lp + 1;
        if (EN(7) && IN(pb + 8)) { PHASE_Z();
            REPS(7) {
            modnorm_rows_bf(WSP(WS_XB), INP(6) + (size_t)l * DM, MOD + (size_t)l * 9 * 6144, WSP(WS_HO), gw, ngw, lane);
            }
            SEAM(pb + 8);
        }
        if (EN(8) && IN(pb + 9)) { PHASE_Z();
            REPS(8) {
            pg8::Gemm g{WSP(WS_HO), WSP(WO_IN), MT, ODD_IN, 2048}; pg8::StaticOrder S; S.init(MT, ODD_IN, G, bx);
            pg8::EpiOddIn E{WSP(WS_UG), WSP(WS_VR), (float*)(ws + WS_STATS)};
            pg8::gemm_phase<pg8::EpiOddIn, pg8::StaticOrder, true, true>(lds, g, S, E);
            }
            SEAM(pb + 9);
        }
        if (EN(9) && IN(pb + 10)) { PHASE_Z();
            sg_phase(lds, vcu, G, WSP(WS_VR), (const float*)(ws + WS_STATS), INP(17) + (size_t)i * 4096, INP(18) + (size_t)i * 4096, WSP(WO_S), INP(20) + (size_t)i * 16 * 128, WSP(WS_UG));
            SEAM(pb + 10);
        }
        if (EN(10) && IN(pb + 11)) { PHASE_Z();
            pg8::Gemm g{WSP(WS_UG), WSP(WO_OUT), MT, 2048, 4096}; pg8::StaticOrder S; S.init(MT, 2048, G, bx);
            pg8::EpiResid E{INP(0), INP(1), WSP(WS_XB), XO, MOD + (size_t)l * 9 * 6144 + 4096, 0, 0};
            pg8::gemm_phase<pg8::EpiResid, pg8::StaticOrder, true, true>(lds, g, S, E);
            if (lp + 1 < 2) { TAIL_WORKERS(); if (cw_ >= 0) CONVERT_EVEN(i + 1, cw_ * 8 + wave, ncw_ * 8); }
            SEAM(pb + 11);
        }
        }
    }
    if (EN(11) && IN(25)) { PHASE_Z(); final_rows(WSP(WS_XB), XO, INP(22), gw, ngw, lane); }
#undef IN
#undef SEAM
}

extern "C" void kernel_launch(void* const* d_in, const int* in_sizes, int n_in, void* d_out, int out_size, void* d_ws, size_t ws_size, hipStream_t stream) {
    static int grid = 0;
    if (grid == 0) {
        if (n_in != 23 || in_sizes[0] != NPR * DM || in_sizes[1] != NSM * DM || out_size != MT * DM + 16 * 2 * 256 * 512 + 16 * 2 * 256 * 64 || ws_size < WS_END) {
            fprintf(stderr, "kernel_launch: shape mismatch (n_in %d, out %d, ws %zu, need %zu); nothing launched\n", n_in, out_size, ws_size, (size_t)WS_END); grid = -1; return; }
        int dev = 0, cus = 0, per_cu = 0;
        if (hipGetDevice(&dev) != hipSuccess || hipDeviceGetAttribute(&cus, hipDeviceAttributeMultiprocessorCount, dev) != hipSuccess) { grid = -1; return; }
        if (hipFuncSetAttribute((const void*)fwd, hipFuncAttributeMaxDynamicSharedMemorySize, LDS_BYTES) != hipSuccess) { fprintf(stderr, "kernel_launch: hipFuncSetAttribute failed\n"); grid = -1; return; }
        if (hipOccupancyMaxActiveBlocksPerMultiprocessor(&per_cu, (const void*)fwd, 512, LDS_BYTES) != hipSuccess || per_cu < 1) fprintf(stderr, "kernel_launch: occupancy query reports %d\n", per_cu);
        (void)hipGetLastError();
        grid = cus;
    }
    if (grid < 0) return;
    if (hipMemsetAsync((char*)d_ws + WS_CTL, 0, CTL_ZERO_BYTES, stream) != hipSuccess) return;
    Args a{};
    for (int i = 0; i < 23; ++i) a.in[i] = (const float*)d_in[i];
    a.out = (float*)d_out; a.ws = (unsigned char*)d_ws;
#if MK_N_LAUNCHES == 1
    a.ph_lo = 0; a.ph_hi = NPH;
    hipLaunchKernelGGL(fwd, dim3(grid), dim3(512), LDS_BYTES, stream, a);
#else
    for (int k = 0; k < NPH; ++k) { a.ph_lo = k; a.ph_hi = k + 1; hipLaunchKernelGGL(fwd, dim3(grid), dim3(512), LDS_BYTES, stream, a); }
#endif
    const hipError_t le = hipPeekAtLastError();
    if (le != hipSuccess) fprintf(stderr, "kernel_launch: launch failed: %s\n", hipGetErrorName(le));
}
```

```cpp
#include <hip/hip_runtime.h>
#include <cstdio>
#include <cstdint>
namespace pg8 {
#define PG8_LAS __attribute__((address_space(3)))
typedef unsigned short bf16_t;
typedef short bf16x8 __attribute__((ext_vector_type(8)));
typedef float f32x4 __attribute__((ext_vector_type(4)));
typedef unsigned u32x4 __attribute__((ext_vector_type(4)));
constexpr int BM = 256, BK = 64, HALF = 128, HTB = HALF * BK * 2  , STAGE_BYTES = 8 * HTB, NXCD = 8, WGM = 8;

__host__ __device__ __forceinline__ int lds_byte(int r, int c) { const int st = (r >> 4) * 2 + (c >> 5), rr = r & 15, cc = c & 31, ob = rr * 64 + cc * 2; return st * 1024 + (ob ^ (((ob >> 9) & 1) << 5)); }
__host__ __device__ __forceinline__ void stage_rc(int b, int& R, int& C) { const int st = b / 1024, sb = b % 1024, swz = sb ^ (((sb >> 9) & 1) << 5); R = (st >> 1) * 16 + swz / 64; C = (st & 1) * 32 + (swz % 64) / 2; }
__host__ __device__ __forceinline__ int perm32(int rho) { const int n = rho >> 4, i = rho & 15; return 8 * (i >> 2) + 4 * n + (i & 3); }

struct Unit { int pm, pn, kh; };
struct Gemm { const bf16_t* A; const bf16_t* Bt; int M, N, K; };

struct StaticOrder {
    int nM, nN, nwg, G, c; unsigned q8, r8, nig, mnig;
    __host__ __device__ void init(int M, int N, int G_, int c_) { nM = M / BM; nN = N / BM; nwg = nM * nN; G = G_; c = c_; q8 = (unsigned)nwg / NXCD; r8 = (unsigned)nwg % NXCD; nig = (unsigned)(WGM * nN);
        mnig = (unsigned)((0x100000000ull + nig - 1) / nig); }
    __host__ __device__ bool next(int i, Unit& u) const {
        const unsigned L = (unsigned)i * (unsigned)G + (unsigned)c; if (L >= (unsigned)nwg) return false;
        const unsigned xcd = L & 7u, off = L >> 3; const unsigned wgid = (xcd < r8 ? xcd * (q8 + 1u) : r8 * (q8 + 1u) + (xcd - r8) * q8) + off;
        const unsigned gid = (unsigned)(((unsigned long long)wgid * mnig) >> 32), rem = wgid - gid * nig;
        u.pm = (int)(gid * WGM + (rem & (WGM - 1))); u.pn = (int)(rem / WGM); u.kh = 0; return true;
    }
    __device__ __forceinline__ void a_ready(const Unit&) const {}
    __device__ __forceinline__ void done(const Unit&) const {}
};
struct TailSplitOrder {
    StaticOrder s; int c; bool split;
    __host__ __device__ void init(int M, int N, int G_, int c_, bool enable) { split = enable && G_ == 256 && M == 144 * BM && N == 8 * BM; c = c_; s.init(split ? 128 * BM : M, N, G_, c_); }
    __host__ __device__ bool next(int i, Unit& u) const {
        if (!split || i < 4) return s.next(i, u);
        if (i > 4) return false;
        const int t = c & 127, x = t & 7, j = t >> 3; u.pm = 128 + 2 * x + (j & 1); u.pn = j >> 1; u.kh = 1 + (c >> 7); return true;
    }
    __device__ __forceinline__ void a_ready(const Unit&) const {}
    __device__ __forceinline__ void done(const Unit&) const {}
};

__device__ __forceinline__ unsigned cvt_pk_bf16(float lo, float hi) { unsigned r; asm volatile("v_cvt_pk_bf16_f32 %0, %1, %2" : "=v"(r) : "v"(lo), "v"(hi)); return r; }
typedef float f32x2 __attribute__((ext_vector_type(2)));
template <class Epi, class Sched, bool ALIGN_EPI = false, bool SP2 = false, bool KSPLIT = false>
__device__ __forceinline__ void gemm_phase(PG8_LAS unsigned char* lds, const Gemm g, const Sched& S, const Epi& E) {
    int tid_ = threadIdx.x; asm volatile("" : "+v"(tid_));
    const int tid = tid_, wid = __builtin_amdgcn_readfirstlane(tid >> 6), lane = tid & 63, wr = wid >> 2, wc = wid & 3, fr = lane & 15, fq = lane >> 4;
    const int K = g.K, nt = K / BK;
    unsigned voffA[2], voffB[2];
#pragma unroll
    for (int i = 0; i < 2; ++i) { int R, C; stage_rc(tid * 16 + i * 8192, R, C); const int Rb = Epi::PERM ? ((R & ~31) + perm32(R & 31)) : R;
        voffA[i] = (unsigned)(R * K + C) * 2u; voffB[i] = (unsigned)(Rb * K + C) * 2u; }
    const size_t kstep = (size_t)(BK * 2);
    const size_t hstep = (size_t)HALF * K * 2;
    const size_t tstep = 2 * hstep;
    const unsigned ldsw = (unsigned)wid * 1024u;
    const int aoff = lds_byte(wr * 64 + fr, fq * 8), boff = lds_byte(wc * 32 + fr, fq * 8);
#define PG8_SA(b, h) (((b) * 2 + (h)) * HTB)
#define PG8_SB(b, h) ((4 + (b) * 2 + (h)) * HTB)
#define PG8_STAGE(bufoff, gbase, voff) do { _Pragma("unroll") for (int _i = 0; _i < 2; ++_i) \
        __builtin_amdgcn_global_load_lds((const unsigned*)((const char*)(gbase) + (voff)[_i]), (PG8_LAS unsigned*)(lds + (bufoff) + ldsw + _i * 8192), 16, 0, 0); } while (0)
#define PG8_LDA(dst, b, h) do { _Pragma("unroll") for (int m = 0; m < 4; ++m) _Pragma("unroll") for (int k = 0; k < 2; ++k) dst[m][k] = *(const PG8_LAS bf16x8*)(lds + PG8_SA(b, h) + aoff + m * 2048 + k * 1024); } while (0)
#define PG8_LDB(dst, b, h) do { _Pragma("unroll") for (int n = 0; n < 2; ++n) _Pragma("unroll") for (int k = 0; k < 2; ++k) dst[n][k] = *(const PG8_LAS bf16x8*)(lds + PG8_SB(b, h) + boff + n * 2048 + k * 1024); } while (0)
#define PG8_MMA(ai, bj, At, Bt) do { __builtin_amdgcn_s_setprio(1); _Pragma("unroll") for (int m = 0; m < 4; ++m) _Pragma("unroll") for (int n = 0; n < 2; ++n) _Pragma("unroll") for (int k = 0; k < 2; ++k) \
        acc[ai][bj][m][n] = __builtin_amdgcn_mfma_f32_16x16x32_bf16(Bt[n][k], At[m][k], acc[ai][bj][m][n], 0, 0, 0); __builtin_amdgcn_s_setprio(0); } while (0)
#define PG8_WAIT_V(n) asm volatile("s_waitcnt vmcnt(" #n ")" ::: "memory")
#define PG8_WAIT_L(n) asm volatile("s_waitcnt lgkmcnt(" #n ")" ::: "memory")
#define PG8_BAR __builtin_amdgcn_s_barrier()
#define PG8_SCHED __builtin_amdgcn_sched_barrier(0)
    Unit cur, nxt; int ui = 0;
    if (!S.next(0, cur)) return;
    f32x4 acc[2][2][4][2];
#pragma unroll
    for (int a = 0; a < 2; ++a)
#pragma unroll
        for (int b = 0; b < 2; ++b)
#pragma unroll
            for (int m = 0; m < 4; ++m)
#pragma unroll
                for (int n = 0; n < 2; ++n) acc[a][b][m][n] = (f32x4){0.f, 0.f, 0.f, 0.f};
    bf16x8 At[4][2], B0[2][2], B1[2][2];
    const size_t k2 = (size_t)K;
    const char* cA = (const char*)g.A + (size_t)cur.pm * tstep + (KSPLIT && cur.kh == 2 ? k2 : 0); const char* cB = (const char*)g.Bt + (size_t)cur.pn * tstep + (KSPLIT && cur.kh == 2 ? k2 : 0);
    S.a_ready(cur);
    if constexpr (SP2) {
        PG8_STAGE(PG8_SB(0, 0), cB, voffB); PG8_STAGE(PG8_SB(0, 1), cB + hstep, voffB); PG8_STAGE(PG8_SA(0, 0), cA, voffA); PG8_STAGE(PG8_SA(0, 1), cA + hstep, voffA);
        if (wr == 1) PG8_BAR;
        PG8_WAIT_V(2); PG8_BAR;
        PG8_STAGE(PG8_SB(1, 0), cB + kstep, voffB); PG8_STAGE(PG8_SA(1, 0), cA + kstep, voffA); PG8_STAGE(PG8_SB(1, 1), cB + hstep + kstep, voffB);
        PG8_WAIT_V(6); PG8_BAR;
    } else {
        PG8_STAGE(PG8_SB(0, 0), cB, voffB); PG8_STAGE(PG8_SA(0, 0), cA, voffA); PG8_STAGE(PG8_SB(0, 1), cB + hstep, voffB); PG8_STAGE(PG8_SA(0, 1), cA + hstep, voffA);
        if (wr == 1) PG8_BAR;
        PG8_WAIT_V(4); PG8_BAR;
        PG8_STAGE(PG8_SB(1, 0), cB + kstep, voffB); PG8_STAGE(PG8_SA(1, 0), cA + kstep, voffA); PG8_STAGE(PG8_SB(1, 1), cB + hstep + kstep, voffB);
        PG8_WAIT_V(6); PG8_BAR;
    }
    for (;;) {
        const bool has_next = S.next(ui + 1, nxt);
        const size_t nk = (KSPLIT && has_next && nxt.kh == 2) ? k2 : 0;
        const char* nA = has_next ? (const char*)g.A + (size_t)nxt.pm * tstep + nk : cA; const char* nB = has_next ? (const char*)g.Bt + (size_t)nxt.pn * tstep + nk : cB;
        const int ntu = (KSPLIT && cur.kh) ? (nt >> 1) : nt;
        for (int t = 0; t < ntu; t += 2) {
            const bool last = (t == ntu - 2);
            const char* a1 = cA + (size_t)(t + 1) * kstep;
            const char* a2 = last ? nA : cA + (size_t)(t + 2) * kstep; const char* b2 = last ? nB : cB + (size_t)(t + 2) * kstep;
            const char* a3 = a2 + kstep; const char* b3 = b2 + kstep;
            if (last && has_next) S.a_ready(nxt);
            if constexpr (SP2) {
            PG8_LDB(B0, 0, 0); PG8_LDB(B1, 0, 1); PG8_SCHED; PG8_LDA(At, 0, 0); PG8_STAGE(PG8_SA(1, 1), a1 + hstep, voffA);
            PG8_WAIT_V(8); PG8_WAIT_L(0); PG8_BAR; PG8_MMA(0, 0, At, B0); PG8_MMA(0, 1, At, B1); PG8_BAR; PG8_SCHED;
            PG8_LDA(At, 0, 1); PG8_STAGE(PG8_SB(0, 0), b2, voffB); PG8_STAGE(PG8_SB(0, 1), b2 + hstep, voffB); PG8_STAGE(PG8_SA(0, 0), a2, voffA);
            PG8_WAIT_V(8); PG8_WAIT_L(0); PG8_BAR; PG8_MMA(1, 0, At, B0); PG8_MMA(1, 1, At, B1); PG8_BAR; PG8_SCHED;
            PG8_LDB(B0, 1, 0); PG8_LDB(B1, 1, 1); PG8_SCHED; PG8_LDA(At, 1, 0); PG8_STAGE(PG8_SA(0, 1), a2 + hstep, voffA);
            PG8_WAIT_V(8); PG8_WAIT_L(0); PG8_BAR; PG8_MMA(0, 0, At, B0); PG8_MMA(0, 1, At, B1); PG8_BAR; PG8_SCHED;
            PG8_LDA(At, 1, 1); PG8_STAGE(PG8_SB(1, 0), b3, voffB); PG8_STAGE(PG8_SB(1, 1), b3 + hstep, voffB); PG8_STAGE(PG8_SA(1, 0), a3, voffA);
            PG8_WAIT_V(8); PG8_WAIT_L(0); PG8_BAR; PG8_MMA(1, 0, At, B0); PG8_MMA(1, 1, At, B1); PG8_BAR; PG8_SCHED;
            } else {
            PG8_LDB(B0, 0, 0); PG8_SCHED; PG8_LDA(At, 0, 0); PG8_STAGE(PG8_SA(1, 1), a1 + hstep, voffA);
            PG8_WAIT_L(8); PG8_BAR; PG8_WAIT_L(0); PG8_MMA(0, 0, At, B0); PG8_BAR; PG8_SCHED;
            PG8_LDB(B1, 0, 1); PG8_STAGE(PG8_SB(0, 0), b2, voffB);
            PG8_BAR; PG8_WAIT_L(0); PG8_MMA(0, 1, At, B1); PG8_BAR;
            PG8_LDA(At, 0, 1); PG8_STAGE(PG8_SA(0, 0), a2, voffA);
            PG8_BAR; PG8_WAIT_L(0); PG8_MMA(1, 0, At, B0); PG8_BAR; PG8_SCHED;
            PG8_STAGE(PG8_SB(0, 1), b2 + hstep, voffB);
            PG8_WAIT_V(6); PG8_BAR; PG8_MMA(1, 1, At, B1); PG8_BAR;
            PG8_LDB(B0, 1, 0); PG8_SCHED; PG8_LDA(At, 1, 0); PG8_STAGE(PG8_SA(0, 1), a2 + hstep, voffA);
            PG8_WAIT_L(8); PG8_BAR; PG8_WAIT_L(0); PG8_MMA(0, 0, At, B0); PG8_BAR; PG8_SCHED;
            PG8_LDB(B1, 1, 1); PG8_STAGE(PG8_SB(1, 0), b3, voffB);
            PG8_BAR; PG8_WAIT_L(0); PG8_MMA(0, 1, At, B1); PG8_BAR;
            PG8_LDA(At, 1, 1); PG8_STAGE(PG8_SA(1, 0), a3, voffA);
            PG8_BAR; PG8_WAIT_L(0); PG8_MMA(1, 0, At, B0); PG8_BAR; PG8_SCHED;
            PG8_STAGE(PG8_SB(1, 1), b3 + hstep, voffB);
            PG8_WAIT_V(6); PG8_BAR; PG8_MMA(1, 1, At, B1); PG8_BAR;
            }
        }
        if constexpr (ALIGN_EPI) { if (wr == 0) PG8_BAR; }
        if constexpr (!Epi::AFTER_DRAIN) { E(acc, cur, wr, wc, fr, fq); S.done(cur); }
        if (!has_next) break;
#pragma unroll
        for (int a = 0; a < 2; ++a)
#pragma unroll
            for (int b = 0; b < 2; ++b)
#pragma unroll
                for (int m = 0; m < 4; ++m)
#pragma unroll
                    for (int n = 0; n < 2; ++n) acc[a][b][m][n] = (f32x4){0.f, 0.f, 0.f, 0.f};
        cur = nxt; cA = nA; cB = nB; ++ui;
        if constexpr (ALIGN_EPI) { if (wr == 1) PG8_BAR; }
    }
    PG8_WAIT_V(0);
    if constexpr (!ALIGN_EPI) { if (wr == 0) PG8_BAR; }
    PG8_BAR;
    if constexpr (Epi::AFTER_DRAIN) { E.fused(acc, cur, wr, wc, fr, fq, lds, wid, lane); S.done(cur); }
#undef PG8_SA
#undef PG8_SB
#undef PG8_STAGE
#undef PG8_LDA
#undef PG8_LDB
#undef PG8_MMA
#undef PG8_WAIT_V
#undef PG8_WAIT_L
#undef PG8_BAR
#undef PG8_SCHED
}
}

#define GAS __attribute__((address_space(1)))
#define LAS __attribute__((address_space(3)))
typedef unsigned short bf16;
typedef unsigned v4u __attribute__((ext_vector_type(4)));
typedef unsigned v2u __attribute__((ext_vector_type(2)));
typedef float f32x2 __attribute__((ext_vector_type(2)));
typedef float f32x4 __attribute__((ext_vector_type(4)));
typedef float f32x16 __attribute__((ext_vector_type(16)));
typedef short bf16x8 __attribute__((ext_vector_type(8)));
typedef short s16x4 __attribute__((ext_vector_type(4)));
typedef GAS unsigned gu32;
#define RLX_AGENT __ATOMIC_RELAXED, __HIP_MEMORY_SCOPE_AGENT
#define LDS_WAIT() asm volatile("s_waitcnt lgkmcnt(0)" ::: "memory")
#define VM_WAIT() asm volatile("s_waitcnt vmcnt(0)" ::: "memory")
#define SBAR() __builtin_amdgcn_sched_barrier(0)
using pg8::cvt_pk_bf16;
__device__ __forceinline__ float bflo(unsigned w) { return __uint_as_float(w << 16); }
__device__ __forceinline__ float bfhi(unsigned w) { return __uint_as_float(w & 0xffff0000u); }
__device__ __forceinline__ float silu_f(float x) { return x * __builtin_amdgcn_rcpf(1.0f + __builtin_amdgcn_exp2f(-1.4426950408889634f * x)); }
__device__ __forceinline__ f32x4 silu4(f32x4 v) { f32x4 r; r.x = silu_f(v.x); r.y = silu_f(v.y); r.z = silu_f(v.z); r.w = silu_f(v.w); return r; }
__device__ __forceinline__ v2u pack4(f32x4 v) { v2u r; r.x = cvt_pk_bf16(v.x, v.y); r.y = cvt_pk_bf16(v.z, v.w); return r; }
__device__ __forceinline__ v4u pack8(f32x4 a, f32x4 b) { v4u r; r.x = cvt_pk_bf16(a.x, a.y); r.y = cvt_pk_bf16(a.z, a.w); r.z = cvt_pk_bf16(b.x, b.y); r.w = cvt_pk_bf16(b.z, b.w); return r; }
__device__ __forceinline__ f32x4 unp_lo(v4u q) { return (f32x4){bflo(q.x), bfhi(q.x), bflo(q.y), bfhi(q.y)}; }
__device__ __forceinline__ f32x4 unp_hi(v4u q) { return (f32x4){bflo(q.z), bfhi(q.z), bflo(q.w), bfhi(q.w)}; }
__device__ __forceinline__ v4u zero4() { v4u z = {0u, 0u, 0u, 0u}; asm volatile("" : "+v"(z)); return z; }
template <int M> __device__ __forceinline__ float xor_lt32(float v) { return __builtin_bit_cast(float, __builtin_amdgcn_ds_swizzle(__builtin_bit_cast(int, v), (M << 10) | 0x1f)); }
__device__ __forceinline__ float sum_halves(float v) { const unsigned u = __builtin_bit_cast(unsigned, v); const auto r = __builtin_amdgcn_permlane32_swap(u, u, false, false);
    return __builtin_bit_cast(float, (unsigned)r[0]) + __builtin_bit_cast(float, (unsigned)r[1]); }
__device__ __forceinline__ float wave_sum(float v) {
    v += xor_lt32<1>(v); v += xor_lt32<2>(v); v += xor_lt32<4>(v); v += xor_lt32<8>(v); v += xor_lt32<16>(v);
    return sum_halves(v);
}

constexpr int DM = 2048, NPR = 4096, NSM = 32768, MT = 36864, KVR = 40960, KVS = 4608;
constexpr int PROW0 = MT - 4096;
constexpr float EPS = 1e-6f;
constexpr int EVEN_IN = 11328, EVEN_NV = 11520, ODD_IN = 12288;
constexpr size_t MiB = 1u << 20;
constexpr size_t WS_CTL = 0, CTL_ZERO_BYTES = 65536;
constexpr size_t WS_MOD = 1 * MiB;
constexpr size_t WS_ROPE = 2 * MiB - 65536;
constexpr size_t WS_W = 2 * MiB;
constexpr size_t WE_IN = WS_W, WE_QB = WS_W + 45 * MiB, WE_KVB = WS_W + 48 * MiB, WE_OUT = WS_W + 52 * MiB;

constexpr size_t WS_CKV = 70 * MiB;
constexpr size_t WS_KPE = 110 * MiB;
constexpr size_t A0 = 116 * MiB;
constexpr size_t WS_MIX = A0, WS_QN = A0 + 288 * MiB, WS_HE = A0 + 324 * MiB, WS_PPB = A0 + 468 * MiB, WS_U1B = A0 + 504 * MiB, WS_QA = A0 + 592 * MiB, WS_CKVR = A0 + 628 * MiB;
constexpr size_t WS_Q = A0 + 324 * MiB, WS_KV = A0 + 432 * MiB;
constexpr size_t WS_HO = 2 * MiB, WS_STATS = 146 * MiB, WS_VR = 164 * MiB, WS_UG = 452 * MiB;
constexpr size_t WS_PEND_E = WS_HE, WS_PEND_O = WS_VR;
constexpr size_t WS_XB = 815 * MiB;
constexpr size_t WS_WO = 959 * MiB;
constexpr size_t WO_IN = WS_WO, WO_OUT = WS_WO + 48 * MiB, WO_S = WS_WO + 64 * MiB;
constexpr size_t WS_END = WS_WO + 65 * MiB;
static_assert(WS_CKVR + 36 * MiB <= WS_XB && WS_UG + 288 * MiB <= WS_XB && WS_XB + 144 * MiB <= WS_WO && WS_END == 1024 * MiB, "map");
static_assert(WS_MOD + 4 * 9 * 6144 * 4 <= WS_ROPE && WS_ROPE + 8192 <= WS_W, "map");
static_assert(WS_Q + (size_t)MT * 1536 * 2 <= WS_KV && WS_KV + (size_t)KVR * 2048 * 2 <= WS_QA, "map");
static_assert(WS_STATS + (size_t)MT * 64 * 8 <= WS_VR && WS_HO + 144 * MiB <= WS_STATS, "map");
constexpr int CW_TMO = 0, CW_BAR = 4096;
constexpr int RING_BYTES = 131072, LDSCTL_OFF = RING_BYTES, MISC_OFF = LDSCTL_OFF + 320, LDS_BYTES = 147456;

namespace att {
constexpr int KN_OFF = 0, KP_OFF = 16384, V_OFF = 24576, SLOT = 40960, SCR_OFF = 2 * SLOT, ATT_LDS = SCR_OFF + 8 * 256;
constexpr float SCALE = 0.07216878364870322f;
constexpr float THR = 8.f;
__device__ __forceinline__ int crow(int r, int hi) { return (r & 3) + 8 * (r >> 2) + 4 * hi; }
__device__ __forceinline__ unsigned cvtpk(float lo, float hi) { unsigned r; asm volatile("v_cvt_pk_bf16_f32 %0, %1, %2" : "=v"(r) : "v"(lo), "v"(hi)); return r; }
__device__ __forceinline__ void partialSM(f32x16& p0, f32x16& p1, float& m_reg, float& mn, float& alpha) {
  constexpr float C = SCALE * 1.4426950408889634f;
  float pmax = p0[0];
#pragma unroll
  for (int r = 1; r < 16; ++r) pmax = fmaxf(pmax, p0[r]);
#pragma unroll
  for (int r = 0; r < 16; ++r) pmax = fmaxf(pmax, p1[r]);
  { auto rr = __builtin_amdgcn_permlane32_swap(__float_as_uint(pmax), __float_as_uint(pmax), false, false);
    pmax = fmaxf(__uint_as_float(rr[0]), __uint_as_float(rr[1])); }
  if (__builtin_expect(__all(pmax - m_reg <= THR / SCALE), 1)) { mn = m_reg; alpha = 1.f; }
  else { mn = fmaxf(m_reg, pmax); alpha = __builtin_amdgcn_exp2f((m_reg - mn) * C); m_reg = mn; }
  float mnC = -mn * C;
#pragma unroll
  for (int r = 0; r < 16; ++r) p0[r] = fmaf(p0[r], C, mnC);
#pragma unroll
  for (int r = 0; r < 16; ++r) p1[r] = fmaf(p1[r], C, mnC);
#pragma unroll
  for (int r = 0; r < 16; ++r) p0[r] = __builtin_amdgcn_exp2f(p0[r]);
}
__device__ __forceinline__ void finishSM(f32x16& p0, f32x16& p1, float alpha, float& l_reg, bf16x8& pa0, bf16x8& pa1, bf16x8& pa2, bf16x8& pa3) {
#pragma unroll
  for (int r = 0; r < 16; ++r) p1[r] = __builtin_amdgcn_exp2f(p1[r]);
  float ps = 0;
#pragma unroll
  for (int r = 0; r < 16; ++r) ps += p0[r];
#pragma unroll
  for (int r = 0; r < 16; ++r) ps += p1[r];
  { auto rr = __builtin_amdgcn_permlane32_swap(__float_as_uint(ps), __float_as_uint(ps), false, false);
    ps = __uint_as_float(rr[0]) + __uint_as_float(rr[1]); }
  l_reg = l_reg * alpha + ps;
#define PK4(P, BASE, OUT) do { unsigned a0 = cvtpk(P[BASE + 0], P[BASE + 1]), a1 = cvtpk(P[BASE + 2], P[BASE + 3]);   \
    unsigned b0 = cvtpk(P[BASE + 4], P[BASE + 5]), b1 = cvtpk(P[BASE + 6], P[BASE + 7]);                              \
    auto r0 = __builtin_amdgcn_permlane32_swap(a0, b0, false, false); auto r1 = __builtin_amdgcn_permlane32_swap(a1, b1, false, false); \
    v4u w = {r0[0], r1[0], r0[1], r1[1]}; OUT = __builtin_bit_cast(bf16x8, w); } while (0)
  PK4(p0, 0, pa0); PK4(p0, 8, pa1); PK4(p1, 0, pa2); PK4(p1, 8, pa3);
#undef PK4
}
#ifndef QK_PF
#define QK_PF 3
#endif
#define ATT_ALL_QF 1
template <int OFF> __device__ __forceinline__ bf16x8 lds_rd128(int addr) { bf16x8 r; asm volatile("ds_read_b128 %0, %1 offset:%2" : "=v"(r) : "v"(addr), "i"(OFF)); return r; }
template <int N> __device__ __forceinline__ void lgkm_wait() { asm volatile("s_waitcnt lgkmcnt(%0)" :: "i"(N) : "memory"); __builtin_amdgcn_sched_barrier(0); }
template <int S> __device__ __forceinline__ void qkt(f32x16& p0, f32x16& p1, int kbn, int kbp, const bf16x8* qr) {
  p0 = f32x16{}; p1 = f32x16{};
  bf16x8 f0[12], f1[12];
#define LDK(d) do { if ((d) < 8) { const int a_ = kbn ^ ((d) << 5); f0[d] = lds_rd128<S * SLOT + KN_OFF>(a_); f1[d] = lds_rd128<S * SLOT + KN_OFF + 8192>(a_); } \
                    else { const int a_ = kbp ^ (((d) - 8) << 5); f0[d] = lds_rd128<S * SLOT + KP_OFF>(a_); f1[d] = lds_rd128<S * SLOT + KP_OFF + 4096>(a_); } } while (0)
#define QSTEP(d0) do { if ((d0) + QK_PF < 12) LDK((d0) + QK_PF); lgkm_wait<2 * ((d0) + QK_PF < 12 ? QK_PF : 11 - (d0))>(); \
    p0 = __builtin_amdgcn_mfma_f32_32x32x16_bf16(f0[d0], qr[d0], p0, 0, 0, 0); p1 = __builtin_amdgcn_mfma_f32_32x32x16_bf16(f1[d0], qr[d0], p1, 0, 0, 0); } while (0)
#pragma unroll
  for (int d = 0; d < QK_PF; ++d) LDK(d);
  QSTEP(0); QSTEP(1); QSTEP(2); QSTEP(3); QSTEP(4); QSTEP(5); QSTEP(6); QSTEP(7); QSTEP(8); QSTEP(9); QSTEP(10); QSTEP(11);
#undef QSTEP
#undef LDK
}
struct StepDma { const unsigned char* kn; const unsigned char* kp; const unsigned char* vp; LAS unsigned char* lk; LAS unsigned char* lv; unsigned okn, okp, ov; bool doK; };
#define ATT_GLDS_(gp, lp) __builtin_amdgcn_global_load_lds((const unsigned*)(gp), (LAS unsigned*)(lp), 16, 0, 0)
#define ATT_GLDS_AT(base, off, lp) do { unsigned o_ = (off); asm volatile("" : "+v"(o_)); __builtin_amdgcn_global_load_lds((const unsigned*)((base) + o_), (LAS unsigned*)(lp), 16, 0, 0); } while (0)
template <int S> __device__ __forceinline__ void qkt_fin(f32x16& n0, f32x16& n1, int kbn, int kbp, const bf16x8* qr,
                                                       f32x16& p0, f32x16& p1, float alpha, float& l_reg, bf16x8& pa0, bf16x8& pa1, bf16x8& pa2, bf16x8& pa3, const StepDma& dm) {
  n0 = f32x16{}; n1 = f32x16{};
  bf16x8 f0[12], f1[12]; float s0, s1, s2, s3;
#define LDK(d) do { if ((d) < 8) { const int a_ = kbn ^ ((d) << 5); f0[d] = lds_rd128<S * SLOT + KN_OFF>(a_); f1[d] = lds_rd128<S * SLOT + KN_OFF + 8192>(a_); } \
                    else { const int a_ = kbp ^ (((d) - 8) << 5); f0[d] = lds_rd128<S * SLOT + KP_OFF>(a_); f1[d] = lds_rd128<S * SLOT + KP_OFF + 4096>(a_); } } while (0)
#define QSTEP(d0) do { if ((d0) + QK_PF < 12) LDK((d0) + QK_PF); lgkm_wait<2 * ((d0) + QK_PF < 12 ? QK_PF : 11 - (d0))>(); \
    n0 = __builtin_amdgcn_mfma_f32_32x32x16_bf16(f0[d0], qr[d0], n0, 0, 0, 0); n1 = __builtin_amdgcn_mfma_f32_32x32x16_bf16(f1[d0], qr[d0], n1, 0, 0, 0); } while (0)
#define EXP4(b) do { p1[b] = __builtin_amdgcn_exp2f(p1[b]); p1[b + 1] = __builtin_amdgcn_exp2f(p1[b + 1]); p1[b + 2] = __builtin_amdgcn_exp2f(p1[b + 2]); p1[b + 3] = __builtin_amdgcn_exp2f(p1[b + 3]); } while (0)
#define SUM8(P, b) (((P[b] + P[b + 1]) + (P[b + 2] + P[b + 3])) + ((P[b + 4] + P[b + 5]) + (P[b + 6] + P[b + 7])))
#define PK4(P, BASE, OUT) do { unsigned a0 = cvtpk(P[BASE + 0], P[BASE + 1]), a1 = cvtpk(P[BASE + 2], P[BASE + 3]);   \
    unsigned b0 = cvtpk(P[BASE + 4], P[BASE + 5]), b1 = cvtpk(P[BASE + 6], P[BASE + 7]);                              \
    auto r0 = __builtin_amdgcn_permlane32_swap(a0, b0, false, false); auto r1 = __builtin_amdgcn_permlane32_swap(a1, b1, false, false); \
    v4u w = {r0[0], r1[0], r0[1], r1[1]}; OUT = __builtin_bit_cast(bf16x8, w); } while (0)
#pragma unroll
  for (int d = 0; d < QK_PF; ++d) LDK(d);
  QSTEP(0); s0 = SUM8(p0, 0); if (dm.doK) ATT_GLDS_AT(dm.kn, dm.okn, dm.lk + KN_OFF);
  QSTEP(1); s1 = SUM8(p0, 8); if (dm.doK) ATT_GLDS_AT(dm.kn + 32 * 4096, dm.okn, dm.lk + KN_OFF + 8192);
  QSTEP(2); PK4(p0, 0, pa0);  if (dm.doK) ATT_GLDS_AT(dm.kp, dm.okp, dm.lk + KP_OFF);
  QSTEP(3); PK4(p0, 8, pa1);  ATT_GLDS_AT(dm.vp, dm.ov, dm.lv);
  QSTEP(4); EXP4(0);          ATT_GLDS_AT(dm.vp + 32 * 4096, dm.ov, dm.lv + 8192);
  QSTEP(5); EXP4(4);
  QSTEP(6); EXP4(8);
  QSTEP(7); EXP4(12);
  QSTEP(8); s2 = SUM8(p1, 0);
  QSTEP(9); s3 = SUM8(p1, 8);
  { float ps = (s0 + s1) + (s2 + s3); auto rr = __builtin_amdgcn_permlane32_swap(__float_as_uint(ps), __float_as_uint(ps), false, false);
    ps = __uint_as_float(rr[0]) + __uint_as_float(rr[1]); l_reg = l_reg * alpha + ps; }
  QSTEP(10); PK4(p1, 0, pa2);
  QSTEP(11); PK4(p1, 8, pa3);
#undef PK4
#undef SUM8
#undef EXP4
#undef QSTEP
#undef LDK
}
__device__ __forceinline__ int v_st(int k, int c) { const int kk = (k & ~0xC) | ((k & 4) << 1) | ((k & 8) >> 1); return ((kk >> 3) * 4 + (c >> 5)) * 512 + ((kk & 7) * 32 + (c & 31)) * 2; }
__device__ __forceinline__ int v_rd_base(int lane) { return ((lane & 3) << 3) | (((lane >> 2) & 3) << 6) | (((lane >> 4) & 1) << 5) | (((lane >> 5) & 1) << 8); }
constexpr int v_rd_off(int d0, int ks, int half) { return d0 * 512 + ks * 4096 + half * 2048; }
template <int OFF> __device__ __forceinline__ s16x4 tr_read(int vb) {
  s16x4 r; asm volatile("ds_read_b64_tr_b16 %0, %1 offset:%2" : "=&v"(r) : "v"(vb), "i"(OFF) : "memory"); return r;
}
struct VGrp { s16x4 l0, h0, l1, h1, l2, h2, l3, h3; };
template <int D0> __device__ __forceinline__ void v_load(VGrp& g, int vb) {
  g.l0 = tr_read<v_rd_off(D0, 0, 0)>(vb); g.h0 = tr_read<v_rd_off(D0, 0, 1)>(vb); g.l1 = tr_read<v_rd_off(D0, 1, 0)>(vb); g.h1 = tr_read<v_rd_off(D0, 1, 1)>(vb);
  g.l2 = tr_read<v_rd_off(D0, 2, 0)>(vb); g.h2 = tr_read<v_rd_off(D0, 2, 1)>(vb); g.l3 = tr_read<v_rd_off(D0, 3, 0)>(vb); g.h3 = tr_read<v_rd_off(D0, 3, 1)>(vb);
}
template <int N> __device__ __forceinline__ void v_wait() { asm volatile("s_waitcnt lgkmcnt(%0)" :: "i"(N) : "memory"); SBAR(); }
__device__ __forceinline__ void v_mma(f32x16& od, const VGrp& g, bf16x8 pa0, bf16x8 pa1, bf16x8 pa2, bf16x8 pa3) {
#define PK(L, H) (bf16x8){L[0], L[1], L[2], L[3], H[0], H[1], H[2], H[3]}
  od = __builtin_amdgcn_mfma_f32_32x32x16_bf16(pa0, PK(g.l0, g.h0), od, 0, 0, 0);
  od = __builtin_amdgcn_mfma_f32_32x32x16_bf16(pa1, PK(g.l1, g.h1), od, 0, 0, 0);
  od = __builtin_amdgcn_mfma_f32_32x32x16_bf16(pa2, PK(g.l2, g.h2), od, 0, 0, 0);
  od = __builtin_amdgcn_mfma_f32_32x32x16_bf16(pa3, PK(g.l3, g.h3), od, 0, 0, 0);
#undef PK
}
__device__ __forceinline__ void pv_d0(f32x16* o, int vb, bf16x8 pa0, bf16x8 pa1, bf16x8 pa2, bf16x8 pa3) {
  VGrp a, b;
  v_load<0>(a, vb); v_load<1>(b, vb);
  v_wait<8>(); v_mma(o[0], a, pa0, pa1, pa2, pa3); SBAR();
  v_load<2>(a, vb);
  v_wait<8>(); v_mma(o[1], b, pa0, pa1, pa2, pa3); SBAR();
  v_load<3>(b, vb);
  v_wait<8>(); v_mma(o[2], a, pa0, pa1, pa2, pa3); SBAR();
  v_wait<0>(); v_mma(o[3], b, pa0, pa1, pa2, pa3);
}
__device__ __forceinline__ void pv_part(f32x16* o, int vb, bf16x8 pa0, bf16x8 pa1, bf16x8 pa2, bf16x8 pa3, f32x16& p0, f32x16& p1, float& m_reg, float& alpha) {
  constexpr float C = SCALE * 1.4426950408889634f;
  VGrp a, b;
  v_load<0>(a, vb); v_load<1>(b, vb);
  v_wait<8>(); v_mma(o[0], a, pa0, pa1, pa2, pa3);
  float pmax = fmaxf(p0[0], p0[1]);
#pragma unroll
  for (int r = 2; r < 16; ++r) pmax = fmaxf(pmax, p0[r]);
#pragma unroll
  for (int r = 0; r < 16; ++r) pmax = fmaxf(pmax, p1[r]);
  asm volatile("" : "+v"(pmax)); SBAR();
  v_load<2>(a, vb);
  v_wait<8>(); v_mma(o[1], b, pa0, pa1, pa2, pa3);
  { auto rr = __builtin_amdgcn_permlane32_swap(__float_as_uint(pmax), __float_as_uint(pmax), false, false); pmax = fmaxf(__uint_as_float(rr[0]), __uint_as_float(rr[1])); }
  const bool keep = __all(pmax - m_reg <= THR / SCALE);
  const float mn = keep ? m_reg : fmaxf(m_reg, pmax);
  alpha = __builtin_amdgcn_exp2f((m_reg - mn) * C); m_reg = mn;
  const float mnC = -mn * C;
#pragma unroll
  for (int r = 0; r < 16; ++r) p0[r] = fmaf(p0[r], C, mnC);
  asm volatile("" : "+v"(p0)); SBAR();
  v_load<3>(b, vb);
  v_wait<8>(); v_mma(o[2], a, pa0, pa1, pa2, pa3);
#pragma unroll
  for (int r = 0; r < 16; ++r) p1[r] = fmaf(p1[r], C, mnC);
#pragma unroll
  for (int r = 0; r < 6; ++r) p0[r] = __builtin_amdgcn_exp2f(p0[r]);
  asm volatile("" : "+v"(p0), "+v"(p1)); SBAR();
  v_wait<0>(); v_mma(o[3], b, pa0, pa1, pa2, pa3);
#pragma unroll
  for (int r = 6; r < 16; ++r) p0[r] = __builtin_amdgcn_exp2f(p0[r]);
  asm volatile("" : "+v"(p0));
}
#define ATT_GLDS(gp, lp) __builtin_amdgcn_global_load_lds((const unsigned*)(gp), (LAS unsigned*)(lp), 16, 0, 0)
#define ATT_BAR() do { asm volatile("" ::: "memory"); __builtin_amdgcn_s_barrier(); asm volatile("" ::: "memory"); } while (0)
__device__ __forceinline__ void unit(LAS unsigned char* lds, const bf16* __restrict__ Qb, int ldq, const unsigned char* __restrict__ Kn, const unsigned char* __restrict__ Vp, const unsigned char* __restrict__ Kp,
                                     int NT, bf16* Ob, int ldo, const bf16* Gb, int ldg) {
  int tid_ = threadIdx.x; asm volatile("" : "+v"(tid_));
  const int tid = tid_, wid = __builtin_amdgcn_readfirstlane(tid >> 6), lane = tid & 63, r32 = lane & 31, hi = lane >> 5;
  LAS float* scr = (LAS float*)(lds + SCR_OFF) + wid * 64; LAS float* li_l = scr; LAS float* al_l = scr + 32;
  float m_reg = -1e30f, l_reg = 0.f; f32x16 o[4] = {}; bf16x8 qr[12];
  { const bf16* Qw = Qb + (size_t)(wid * 32 + r32) * ldq + hi * 8;
#pragma unroll
    for (int d0 = 0; d0 < 12; ++d0) qr[d0] = *(const bf16x8*)(Qw + d0 * 16); }
  const unsigned offKn = (unsigned)((4 * wid + (lane >> 4)) * 4096 + (((lane & 15) ^ ((4 * wid + (lane >> 4)) & 15)) << 4));
  const unsigned offKp = (unsigned)((8 * wid + (lane >> 3)) * 128 + (((lane & 7) ^ (((8 * wid + (lane >> 3)) >> 1) & 7)) << 4));
  unsigned offV; { const int kk = 8 * (wid >> 1) + ((lane & 31) >> 2); const int k = (kk & ~0xC) | ((kk & 4) << 1) | ((kk & 8) >> 1); const int c = (2 * (wid & 1) + (lane >> 5)) * 32 + 8 * (lane & 3); offV = (unsigned)(k * 4096 + c * 2); }
  const int vb0 = (int)(unsigned)(uintptr_t)(lds + V_OFF) + v_rd_base(lane);
  const int kbn = (int)(unsigned)(uintptr_t)lds + r32 * 256 + ((hi ^ (r32 & 1)) << 4) + (((r32 & 15) >> 1) << 5);
  const int kbp = (int)(unsigned)(uintptr_t)lds + r32 * 128 + ((hi ^ ((r32 >> 1) & 1)) << 4) + ((((r32 >> 1) & 7) >> 1) << 5);
#define ISSUE_K(j, s) do { const unsigned char* g_ = Kn + (size_t)(j) * (64 * 4096) + offKn; LAS unsigned char* l_ = lds + (s) * SLOT + KN_OFF + wid * 1024; \
    ATT_GLDS(g_, l_); ATT_GLDS(g_ + 32 * 4096, l_ + 8192); ATT_GLDS(Kp + (size_t)(j) * (64 * 128) + offKp, lds + (s) * SLOT + KP_OFF + wid * 1024); } while (0)
#define ISSUE_V(j, s) do { const unsigned char* g_ = Vp + (size_t)(j) * (64 * 4096) + offV; LAS unsigned char* l_ = lds + (s) * SLOT + V_OFF + wid * 1024; \
    ATT_GLDS(g_, l_); ATT_GLDS(g_ + 32 * 4096, l_ + 8192); } while (0)
#define RESC(a) do { if (__any((a) < 1.f)) { if (hi == 0) al_l[r32] = (a); asm volatile("s_waitcnt lgkmcnt(0)" ::: "memory"); \
    _Pragma("unroll") for (int d = 0; d < 4; ++d) _Pragma("unroll") for (int r = 0; r < 16; ++r) o[d][r] *= al_l[crow(r, hi)]; } } while (0)
#define STEP_END() do { asm volatile("s_waitcnt vmcnt(0)" ::: "memory"); ATT_BAR(); } while (0)
  f32x16 pA0, pA1, pB0, pB1; float mnA, mnB, alA, alB; bf16x8 pa0, pa1, pa2, pa3;
#define STEP_QF(N0, N1, mnN, alN, P0, P1, alP, kslot, vbase, DM) do { SBAR(); qkt_fin<kslot>(N0, N1, kbn, kbp, qr, P0, P1, alP, l_reg, pa0, pa1, pa2, pa3, DM); SBAR(); \
    pv_part(o, vbase, pa0, pa1, pa2, pa3, N0, N1, m_reg, alN); SBAR(); RESC(alN); } while (0)
#define MK_DMA(jk, sk, jv, sv, dok) StepDma{Kn + (size_t)(jk) * (64 * 4096), Kp + (size_t)(jk) * (64 * 128), Vp + (size_t)(jv) * (64 * 4096), \
    lds + (sk) * SLOT + wid * 1024, lds + (sv) * SLOT + V_OFF + wid * 1024, offKn, offKp, offV, (dok)}
#define MAINLOOP_QF() do { \
  ISSUE_K(0, 0); STEP_END(); \
  ISSUE_K(1, 1); ISSUE_V(0, 0); \
  qkt<0>(pA0, pA1, kbn, kbp, qr); partialSM(pA0, pA1, m_reg, mnA, alA); \
  STEP_END(); \
  for (int j = 1; j + 1 < NT; j += 2) { \
    { const StepDma dm_ = MK_DMA(j + 1, 0, j, 1, true); STEP_QF(pB0, pB1, mnB, alB, pA0, pA1, alA, 1, vb0, dm_); } STEP_END(); \
    { const StepDma dm_ = MK_DMA(j + 2, 1, j + 1, 0, j + 2 < NT); STEP_QF(pA0, pA1, mnA, alA, pB0, pB1, alB, 0, vb0 + SLOT, dm_); } STEP_END(); \
  } \
  { const StepDma dm_ = MK_DMA(NT - 1, 0, NT - 1, 1, false); STEP_QF(pB0, pB1, mnB, alB, pA0, pA1, alA, 1, vb0, dm_); } STEP_END(); \
  finishSM(pB0, pB1, alB, l_reg, pa0, pa1, pa2, pa3); SBAR(); \
  pv_d0(o, vb0 + SLOT, pa0, pa1, pa2, pa3); } while (0)
#define STEP_FQ(N0, N1, mnN, alN, P0, P1, alP, kslot, vbase) do { finishSM(P0, P1, alP, l_reg, pa0, pa1, pa2, pa3); SBAR(); pv_d0(o, vbase, pa0, pa1, pa2, pa3); SBAR(); \
    qkt<kslot>(N0, N1, kbn, kbp, qr); partialSM(N0, N1, m_reg, mnN, alN); RESC(alN); } while (0)
#define MAINLOOP(STEP) do { \
  ISSUE_K(0, 0); STEP_END(); \
  ISSUE_K(1, 1); ISSUE_V(0, 0); \
  qkt<0>(pA0, pA1, kbn, kbp, qr); partialSM(pA0, pA1, m_reg, mnA, alA); \
  STEP_END(); \
  for (int j = 1; j + 1 < NT; j += 2) { \
    ISSUE_K(j + 1, 0); ISSUE_V(j, 1); \
    STEP(pB0, pB1, mnB, alB, pA0, pA1, alA, 1, vb0); STEP_END(); \
    if (j + 2 < NT) ISSUE_K(j + 2, 1); \
    ISSUE_V(j + 1, 0); \
    STEP(pA0, pA1, mnA, alA, pB0, pB1, alB, 0, vb0 + SLOT); STEP_END(); \
  } \
  ISSUE_V(NT - 1, 1); \
  STEP(pB0, pB1, mnB, alB, pA0, pA1, alA, 1, vb0); STEP_END(); \
  finishSM(pB0, pB1, alB, l_reg, pa0, pa1, pa2, pa3); SBAR(); \
  pv_d0(o, vb0 + SLOT, pa0, pa1, pa2, pa3); } while (0)
#if defined(ATT_ALL_QF)
  MAINLOOP_QF();
#elif defined(ATT_ALL_FQ)
  MAINLOOP(STEP_FQ);
#else
  MAINLOOP(STEP_FQ);
#endif
#undef MAINLOOP
#undef MAINLOOP_QF
#undef MK_DMA
#undef STEP_QF
#undef STEP_FQ
  if (hi == 0) li_l[r32] = l_reg; asm volatile("s_waitcnt lgkmcnt(0)" ::: "memory");
  float rli[16];
#pragma unroll
  for (int r = 0; r < 16; ++r) rli[r] = __builtin_amdgcn_rcpf(li_l[crow(r, hi)]);
  ATT_BAR();
  { LAS unsigned char* stg = lds + wid * 8192;
#pragma unroll
    for (int r = 0; r < 16; ++r) {
#pragma unroll
      for (int d0 = 0; d0 < 4; ++d0) *(LAS bf16*)(stg + crow(r, hi) * 256 + (d0 * 32 + r32) * 2) = (bf16)(cvtpk(o[d0][r] * rli[r], 0.f) & 0xffffu); }
    asm volatile("s_waitcnt lgkmcnt(0)" ::: "memory");
#pragma unroll
    for (int j = 0; j < 8; ++j) { const int id = lane + 64 * j, row = id >> 4, cg = id & 15, orow = wid * 32 + row;
      const v4u a = *(const LAS v4u*)(stg + row * 256 + cg * 16), g = *(const v4u*)(Gb + (size_t)orow * ldg + cg * 8);
      v4u w; w.x = cvtpk(bflo(a.x) * bflo(g.x), bfhi(a.x) * bfhi(g.x)); w.y = cvtpk(bflo(a.y) * bflo(g.y), bfhi(a.y) * bfhi(g.y));
      w.z = cvtpk(bflo(a.z) * bflo(g.z), bfhi(a.z) * bfhi(g.z)); w.w = cvtpk(bflo(a.w) * bflo(g.w), bfhi(a.w) * bfhi(g.w));
      *(v4u*)(Ob + (size_t)orow * ldo + cg * 8) = w; } }
  ATT_BAR();
#undef ISSUE_K
#undef ISSUE_V
#undef RESC
#undef STEP_END
}
}

namespace pg8 {
__device__ __forceinline__ float dpp_shr1(float v) { return __builtin_bit_cast(float, __builtin_amdgcn_update_dpp(0, __builtin_bit_cast(int, v), 0x111, 0xf, 0xf, true)); }
__device__ __forceinline__ float dpp_shl1(float v) { return __builtin_bit_cast(float, __builtin_amdgcn_update_dpp(0, __builtin_bit_cast(int, v), 0x101, 0xf, 0xf, true)); }
__device__ __forceinline__ int kvrow_of(int row) { return row < NPR ? row : NPR + ((row - NPR) >> 12) * KVS + 512 + ((row - NPR) & 4095); }
struct EpiEvenIn {
    static constexpr bool PERM = false, AFTER_DRAIN = false;
    bf16 *MIX, *PPB, *U1B, *QA, *CKVR, *KPE; float* nkpe; const float* rope; const float* cw;
    __device__ __forceinline__ void operator()(const f32x4 (&acc)[2][2][4][2], const Unit& u, int wr, int wc, int fr, int fq) const {
        const int row0 = u.pm * BM + wr * 64 + fr, pn = u.pn;
        if (pn < 32) {
            const int ch = 64 * pn + 16 * wc + 4 * fq;
            const f32x4 w0 = *(const f32x4*)(cw + ch), w1 = *(const f32x4*)(cw + 2048 + ch), w2 = *(const f32x4*)(cw + 4096 + ch);
            const bool edge = fr == 0 || fr == 15, nearb = edge || fr == 1 || fr == 14; const int slot = fr < 2 ? fr : fr - 12;
#pragma unroll
            for (int ai = 0; ai < 2; ++ai)
#pragma unroll
                for (int m = 0; m < 4; ++m) { const int row = row0 + ai * HALF + m * 16;
                    const f32x4 cb = acc[ai][0][m][0], cc = acc[ai][0][m][1], cx = acc[ai][1][m][0], cg = acc[ai][1][m][1];
                    const f32x4 p = cc * cx, u1 = cb * silu4(cg);
                    const f32x4 pm = {dpp_shr1(p.x), dpp_shr1(p.y), dpp_shr1(p.z), dpp_shr1(p.w)};
                    const f32x4 pp = {dpp_shl1(p.x), dpp_shl1(p.y), dpp_shl1(p.z), dpp_shl1(p.w)};
                    if (!edge) *(v2u*)(MIX + (size_t)row * 4096 + ch) = pack4(u1 * (w0 * pm + w1 * p + w2 * pp));
                    if (nearb) *(v2u*)(PPB + ((size_t)(row >> 4) * 4 + slot) * 2048 + ch) = pack4(p);
                    if (edge) *(v2u*)(U1B + ((size_t)(row >> 4) * 2 + (fr == 15 ? 1 : 0)) * 2048 + ch) = pack4(u1); }
        } else if (pn < 36) {
            bf16* dst = pn < 34 ? QA : CKVR; const int col = (pn & 1) * 256 + 32 * wc + 8 * fq;
#pragma unroll
            for (int ai = 0; ai < 2; ++ai)
#pragma unroll
                for (int m = 0; m < 4; ++m) { bf16* rp = dst + (size_t)(row0 + ai * HALF + m * 16) * 512 + col;
#pragma unroll
                    for (int bj = 0; bj < 2; ++bj) *(v4u*)(rp + bj * HALF) = pack8(acc[ai][bj][m][0], acc[ai][bj][m][1]); }
        } else if (pn == 36) {
            if (wc < 2) {
#pragma unroll
                for (int ai = 0; ai < 2; ++ai)
#pragma unroll
                    for (int m = 0; m < 4; ++m) { const int row = row0 + ai * HALF + m * 16; f32x4 x0 = acc[ai][0][m][0], x1 = acc[ai][0][m][1];
                        if (row < NPR) { float* op = nkpe + (size_t)(row >> 8) * (2 * 256 * 64) + (row & 255) * 64 + 32 * wc + 4 * fq; *(f32x4*)op = x0; *(f32x4*)(op + 16) = x1; }
                        else { const int nt = (row - NPR) & 4095, pos = wc == 0 ? (nt >> 6) : (nt & 63); const float* cs = rope + (pos * 16 + 4 * fq) * 2;
                            const f32x4 t0 = *(const f32x4*)cs, t1 = *(const f32x4*)(cs + 4); const f32x4 c = {t0.x, t0.z, t1.x, t1.z}, s = {t0.y, t0.w, t1.y, t1.w};
                            const f32x4 y0 = x0 * c - x1 * s, y1 = x1 * c + x0 * s; x0 = y0; x1 = y1; }
                        bf16* kp = KPE + (size_t)kvrow_of(row) * 64 + 32 * wc + 4 * fq; *(v2u*)kp = pack4(x0); *(v2u*)(kp + 16) = pack4(x1); }
            }
        } else {
            const int col = 2048 + (pn - 37) * 256 + 32 * wc + 8 * fq;
#pragma unroll
            for (int ai = 0; ai < 2; ++ai)
#pragma unroll
                for (int m = 0; m < 4; ++m) { bf16* rp = MIX + (size_t)(row0 + ai * HALF + m * 16) * 4096 + col;
#pragma unroll
                    for (int bj = 0; bj < 2; ++bj) *(v4u*)(rp + bj * HALF) = pack8(silu4(acc[ai][bj][m][0]), silu4(acc[ai][bj][m][1])); }
        }
    }
};
struct EpiStore {
    static constexpr bool PERM = false, AFTER_DRAIN = false;
    bf16* O; int ldc;
    __device__ __forceinline__ void operator()(const f32x4 (&acc)[2][2][4][2], const Unit& u, int wr, int wc, int fr, int fq) const {
        const int row0 = u.pm * BM + wr * 64 + fr, col = u.pn * BM + 32 * wc + 8 * fq;
#pragma unroll
        for (int ai = 0; ai < 2; ++ai)
#pragma unroll
            for (int m = 0; m < 4; ++m) { bf16* rp = O + (size_t)(row0 + ai * HALF + m * 16) * ldc + col;
#pragma unroll
                for (int bj = 0; bj < 2; ++bj) *(v4u*)(rp + bj * HALF) = pack8(acc[ai][bj][m][0], acc[ai][bj][m][1]); }
    }
};
struct EpiQ {
    static constexpr bool PERM = false, AFTER_DRAIN = false;
    bf16* Q; const float* rope;
    __device__ __forceinline__ void operator()(const f32x4 (&acc)[2][2][4][2], const Unit& u, int wr, int wc, int fr, int fq) const {
        const int row0 = u.pm * BM + wr * 64 + fr;
#pragma unroll
        for (int bj = 0; bj < 2; ++bj) { const int gi = 8 * u.pn + 4 * bj + wc, hl = gi / 6, sub = gi - 6 * hl;
            if (sub < 4) {
#pragma unroll
                for (int ai = 0; ai < 2; ++ai)
#pragma unroll
                    for (int m = 0; m < 4; ++m) *(v4u*)(Q + (size_t)(row0 + ai * HALF + m * 16) * 1536 + hl * 192 + 32 * sub + 8 * fq) = pack8(acc[ai][bj][m][0], acc[ai][bj][m][1]);
            } else { const int h = sub - 4;
#pragma unroll
                for (int ai = 0; ai < 2; ++ai)
#pragma unroll
                    for (int m = 0; m < 4; ++m) { const int row = row0 + ai * HALF + m * 16; f32x4 x0 = acc[ai][bj][m][0], x1 = acc[ai][bj][m][1];
                        if (row >= NPR) { const int nt = (row - NPR) & 4095, pos = h == 0 ? (nt >> 6) : (nt & 63); const float* cs = rope + (pos * 16 + 4 * fq) * 2;
                            const f32x4 t0 = *(const f32x4*)cs, t1 = *(const f32x4*)(cs + 4); const f32x4 c = {t0.x, t0.z, t1.x, t1.z}, s = {t0.y, t0.w, t1.y, t1.w};
                            const f32x4 y0 = x0 * c - x1 * s, y1 = x1 * c + x0 * s; x0 = y0; x1 = y1; }
                        bf16* qp = Q + (size_t)row * 1536 + hl * 192 + 128 + 32 * h + 4 * fq; *(v2u*)qp = pack4(x0); *(v2u*)(qp + 16) = pack4(x1); }
            }
        }
    }
};
struct EpiResid {
    static constexpr bool PERM = false, AFTER_DRAIN = false;
    const float* xp; const float* xs; bf16* xb; float* xo; const float* gate; int first, last; float* pend;
    __device__ __forceinline__ void operator()(const f32x4 (&acc)[2][2][4][2], const Unit& u, int wr, int wc, int fr, int fq) const {
        const int row0 = u.pm * BM + wr * 64 + fr, col0 = u.pn * BM + wc * 32 + 8 * fq;
        if (u.kh == 2) {
            const float* gq = gate + (size_t)8 * 6144 + col0;
#pragma unroll
            for (int bj = 0; bj < 2; ++bj) { const f32x4 g0 = *(const f32x4*)(gq + bj * HALF), g1 = *(const f32x4*)(gq + bj * HALF + 4);
#pragma unroll
                for (int ai = 0; ai < 2; ++ai)
#pragma unroll
                    for (int m = 0; m < 4; ++m) { float* pp = pend + (size_t)(row0 + ai * HALF + m * 16 - PROW0) * DM + col0 + bj * HALF;
                        *(f32x4*)pp = g0 * acc[ai][bj][m][0]; *(f32x4*)(pp + 4) = g1 * acc[ai][bj][m][1]; } }
            return;
        }
        const int cr = u.pm < 16 ? 0 : 1 + ((u.pm - 16) >> 4);
        const float* xin = u.pm < 16 ? xp : xs - (size_t)NPR * DM;
        const float* gp = gate + (size_t)cr * 6144 + col0;
        f32x4 gv[2][2];
#pragma unroll
        for (int bj = 0; bj < 2; ++bj)
#pragma unroll
            for (int n = 0; n < 2; ++n) gv[bj][n] = *(const f32x4*)(gp + bj * HALF + n * 4);
#pragma unroll
        for (int ai = 0; ai < 2; ++ai)
#pragma unroll
            for (int m = 0; m < 4; ++m) { const size_t off = (size_t)(row0 + ai * HALF + m * 16) * DM + col0;
#pragma unroll
                for (int bj = 0; bj < 2; ++bj) { f32x4 a, b;
                    if (first) { a = *(const f32x4*)(xin + off + bj * HALF); b = *(const f32x4*)(xin + off + bj * HALF + 4); }
                    else { const v4u w = *(const v4u*)(xb + off + bj * HALF); a = (f32x4){bflo(w.x), bfhi(w.x), bflo(w.y), bfhi(w.y)}; b = (f32x4){bflo(w.z), bfhi(w.z), bflo(w.w), bfhi(w.w)}; }
                    a += gv[bj][0] * acc[ai][bj][m][0]; b += gv[bj][1] * acc[ai][bj][m][1];
                    if (last) { *(f32x4*)(xo + off + bj * HALF) = a; *(f32x4*)(xo + off + bj * HALF + 4) = b; }
                    else *(v4u*)(xb + off + bj * HALF) = pack8(a, b); }
                asm volatile("" ::: "memory"); }
    }
};
struct EpiOddIn {
    static constexpr bool PERM = false, AFTER_DRAIN = false;
    bf16 *UG, *VR; float* stats;
    __device__ __forceinline__ void operator()(const f32x4 (&acc)[2][2][4][2], const Unit& u, int wr, int wc, int fr, int fq) const {
        const int row0 = u.pm * BM + wr * 64 + fr, pn = u.pn;
        if (pn < 32) {
            const int col = 128 * pn + 32 * wc + 8 * fq;
#pragma unroll
            for (int ai = 0; ai < 2; ++ai)
#pragma unroll
                for (int m = 0; m < 4; ++m) *(v4u*)(UG + (size_t)(row0 + ai * HALF + m * 16) * 4096 + col) = pack8(acc[ai][0][m][0] * silu4(acc[ai][1][m][0]), acc[ai][0][m][1] * silu4(acc[ai][1][m][1]));
        } else {
            const int col = (pn - 32) * 256 + 32 * wc + 8 * fq;
#pragma unroll
            for (int ai = 0; ai < 2; ++ai)
#pragma unroll
                for (int m = 0; m < 4; ++m) { const int row = row0 + ai * HALF + m * 16; bf16* rp = VR + (size_t)row * 4096 + col; float s = 0.f, q = 0.f;
#pragma unroll
                    for (int bj = 0; bj < 2; ++bj) { const f32x4 a = acc[ai][bj][m][0], b = acc[ai][bj][m][1]; *(v4u*)(rp + bj * HALF) = pack8(a, b);
                        s += (a.x + a.y) + (a.z + a.w) + (b.x + b.y) + (b.z + b.w); q += (a.x * a.x + a.y * a.y) + (a.z * a.z + a.w * a.w) + (b.x * b.x + b.y * b.y) + (b.z * b.z + b.w * b.w); }
                    s += xor_lt32<16>(s); s = sum_halves(s); q += xor_lt32<16>(q); q = sum_halves(q);
                    if (fq == 0) *(f32x2*)(stats + ((size_t)row * 64 + (pn - 32) * 4 + wc) * 2) = (f32x2){s, q}; }
        }
    }
};
}

#define XB_TMO      128
#define XB_XCNT(j)  (256  + 64 * (j))
#define XB_XSUB(j)  (1280 + 64 * (j))
#define XB_XGEN(j)  (2304 + 64 * (j))
#define XB_TOP      3328
#define XB_TOPGEN   3392
#define XCD_BAR_WORDS 3456
#define XB_SPIN_CAP (1u << 18)

__device__ __forceinline__ unsigned xb_ld(unsigned* p)              { return __hip_atomic_load(p, __ATOMIC_RELAXED, __HIP_MEMORY_SCOPE_AGENT); }
__device__ __forceinline__ unsigned xb_add(unsigned* p, unsigned v) { return __hip_atomic_fetch_add(p, v, __ATOMIC_RELAXED, __HIP_MEMORY_SCOPE_AGENT); }
__device__ __forceinline__ unsigned xb_xcc_id() { return (unsigned)__builtin_amdgcn_s_getreg((3 << 11) | 20) & 0xFu; }
#define XB_SPIN(cond, bar) do { unsigned _sp = 0; while (cond) { __builtin_amdgcn_s_sleep(1); \
    if ((++_sp & 255u) == 0u) { if (xb_ld(&(bar)[XB_TMO])) break; if (_sp > XB_SPIN_CAP) { atomicAdd(&(bar)[XB_TMO], 1u); break; } } } } while (0)

struct XcdBarrier {
    unsigned* bar; unsigned x;
    volatile LAS unsigned* st;
};

__device__ __forceinline__ XcdBarrier xcd_barrier_post(unsigned* bar, volatile LAS unsigned* st) {
    XcdBarrier b; b.bar = bar; b.x = xb_xcc_id(); b.st = st;
    if (threadIdx.x == 0) (void)xb_add(&bar[XB_XCNT(b.x)], 1u);
    return b;
}
__device__ __forceinline__ void xcd_barrier_complete(unsigned* bar, unsigned x, unsigned& nloc, unsigned& nx) {
    const unsigned G = gridDim.x * gridDim.y * gridDim.z;
    unsigned sum, cnt, mine, sp = 0u;
    for (;;) {
        sum = 0u; cnt = 0u; mine = 0u;
#pragma unroll
        for (unsigned j = 0; j < 16; ++j) { const unsigned c = xb_ld(&bar[XB_XCNT(j)]); sum += c; cnt += (c > 0u) ? 1u : 0u; mine = (j == x) ? c : mine; }
        if (sum == G) break;
        __builtin_amdgcn_s_sleep(1);
        if ((++sp & 255u) == 0u) { if (xb_ld(&bar[XB_TMO])) break; if (sp > XB_SPIN_CAP) { atomicAdd(&bar[XB_TMO], 1u); break; } }
    }
    nloc = mine > 0u ? mine : 1u; nx = cnt > 0u ? cnt : 1u;
}

__device__ __forceinline__ void xcd_barrier(const XcdBarrier& b) {
    asm volatile("s_waitcnt vmcnt(0)" ::: "memory");
    __syncthreads();
    if (threadIdx.x == 0) {
        unsigned* bar = b.bar;
        __builtin_amdgcn_s_waitcnt(0);
        unsigned nloc = b.st[0], nx = b.st[1];
        if (nloc == 0u) { xcd_barrier_complete(bar, b.x, nloc, nx); b.st[0] = nloc; b.st[1] = nx; }
        const unsigned old = xb_add(&bar[XB_XSUB(b.x)], 1u);
        const unsigned gen = old / nloc;
        if (old + 1u == (gen + 1u) * nloc) {
            __builtin_amdgcn_fence(__ATOMIC_RELEASE, "agent");
            asm volatile("s_waitcnt vmcnt(0)" ::: "memory");
            const unsigned og = xb_add(&bar[XB_TOP], 1u);
            const unsigned tg = og / nx;
            if (og + 1u == (tg + 1u) * nx) xb_add(&bar[XB_TOPGEN], 1u);
            else XB_SPIN(xb_ld(&bar[XB_TOPGEN]) == tg, bar);
            __builtin_amdgcn_fence(__ATOMIC_ACQUIRE, "agent");
            xb_add(&bar[XB_XGEN(b.x)], 1u);
            asm volatile("s_waitcnt vmcnt(0)" ::: "memory");
        } else {
            XB_SPIN(xb_ld(&bar[XB_XGEN(b.x)]) == gen, bar);
            __builtin_amdgcn_fence(__ATOMIC_ACQUIRE, "agent");
            asm volatile("s_waitcnt vmcnt(0)" ::: "memory");
        }
    }
    __syncthreads();
}

__device__ __forceinline__ int inv32(int j) { return 16 * ((j >> 2) & 1) + 4 * (j >> 3) + (j & 3); }
struct DestEvenIn { __device__ __forceinline__ int operator()(int n) const {
    if (n < 8192) { const int seg = n >> 11, ch = n & 2047, t = ch >> 6, ci = ch & 63; return 256 * t + 128 * (seg >> 1) + 32 * (ci >> 4) + 16 * (seg & 1) + (ci & 15); }
    if (n < 9216) return (n & ~31) + inv32(n & 31);
    if (n < 9280) return n;
    const int m = n - 9280; return 9472 + (m & ~31) + inv32(m & 31); } };
struct DestQb { __device__ __forceinline__ int operator()(int n) const { const int h = n / 192, j = n - 192 * h; return j < 128 ? 192 * h + (j & ~31) + inv32(j & 31) : n; } };
struct DestP32 { __device__ __forceinline__ int operator()(int n) const { return (n & ~31) + inv32(n & 31); } };
struct DestId { __device__ __forceinline__ int operator()(int n) const { return n; } };
struct DestOddIn { __device__ __forceinline__ int operator()(int n) const {
    if (n < 4096) return 256 * (n >> 7) + ((n & 127) & ~31) + inv32(n & 31);
    if (n < 8192) { const int ch = n - 4096; return 8192 + (ch & ~31) + inv32(ch & 31); }
    const int ch = n - 8192; return 256 * (ch >> 7) + 128 + ((ch & 127) & ~31) + inv32(ch & 31); } };
template <class DestFn> __device__ __forceinline__ void cvt_item(const float* __restrict__ W, int K, int N, bf16* __restrict__ WT, const DestFn& dest, const float* __restrict__ kscale, LAS float* scr, int item, int lane) {
    const int nblk = N / 32, kb = item / nblk, nb = item - kb * nblk, k0 = 64 * kb, n0 = 32 * nb;
    f32x4 v[8];
#pragma unroll
    for (int i = 0; i < 8; ++i) v[i] = *(const f32x4*)(W + (size_t)(k0 + 8 * i + (lane >> 3)) * N + n0 + 4 * (lane & 7));
#pragma unroll
    for (int i = 0; i < 8; ++i) { const int kk = 8 * i + (lane >> 3); f32x4 x = v[i]; if (kscale) x = x * kscale[k0 + kk]; LAS float* p = scr + kk * 33 + 4 * (lane & 7); p[0] = x.x; p[1] = x.y; p[2] = x.z; p[3] = x.w; }
    LDS_WAIT(); asm volatile("" ::: "memory");
    const int c = lane & 7;
#pragma unroll
    for (int j = 0; j < 4; ++j) { const int n = (lane >> 3) + 8 * j; const LAS float* s = scr + (8 * c) * 33 + n;
        v4u o; o.x = cvt_pk_bf16(s[0 * 33], s[1 * 33]); o.y = cvt_pk_bf16(s[2 * 33], s[3 * 33]); o.z = cvt_pk_bf16(s[4 * 33], s[5 * 33]); o.w = cvt_pk_bf16(s[6 * 33], s[7 * 33]);
        *(v4u*)(WT + (size_t)dest(n0 + n) * K + k0 + 8 * c) = o; }
    LDS_WAIT(); asm volatile("" ::: "memory");
}
__device__ __forceinline__ void modnorm_rows(const float* __restrict__ xp, const float* __restrict__ xs, const float* __restrict__ xo, int first, const float* __restrict__ g, const float* __restrict__ mod  ,
                                             bf16* __restrict__ H, int gw, int ngw, int lane) {
    for (int rb = gw; rb < MT; rb += 2 * ngw) {
        f32x4 v[2][8];
#pragma unroll
        for (int t = 0; t < 2; ++t) { const int row = rb + t * ngw < MT ? rb + t * ngw : rb;
            const float* xr = first ? (row < NPR ? xp + (size_t)row * DM : xs + (size_t)(row - NPR) * DM) : xo + (size_t)row * DM;
#pragma unroll
            for (int j = 0; j < 8; ++j) v[t][j] = *(const f32x4*)(xr + 4 * lane + 256 * j); }
#pragma unroll
        for (int t = 0; t < 2; ++t) { const int row = rb + t * ngw; if (row >= MT) break;
            const int cr = row < NPR ? 0 : 1 + ((row - NPR) >> 12);
            const float* md = mod + (size_t)cr * 6144; float ss = 0.f;
#pragma unroll
            for (int j = 0; j < 8; ++j) ss += (v[t][j].x * v[t][j].x + v[t][j].y * v[t][j].y) + (v[t][j].z * v[t][j].z + v[t][j].w * v[t][j].w);
            const float rstd = __builtin_amdgcn_rsqf(wave_sum(ss) * (1.f / DM) + EPS);
#pragma unroll
            for (int j = 0; j < 8; ++j) { const int c = 4 * lane + 256 * j; const f32x4 gg = *(const f32x4*)(g + c), sh = *(const f32x4*)(md + c), sc = *(const f32x4*)(md + 2048 + c);
                *(v2u*)(H + (size_t)row * DM + c) = pack4(v[t][j] * rstd * gg * (sc + 1.f) + sh); } }
    }
}
__device__ __forceinline__ void modnorm_rows_bf(bf16* xb, const float* __restrict__ g, const float* __restrict__ mod  , bf16* __restrict__ H, int gw, int ngw, int lane, const float* pend = nullptr) {
    for (int rb = gw; rb < MT; rb += 2 * ngw) {
        v4u v[2][4];
#pragma unroll
        for (int t = 0; t < 2; ++t) { const int row = rb + t * ngw < MT ? rb + t * ngw : rb;
#pragma unroll
            for (int j = 0; j < 4; ++j) v[t][j] = *(const v4u*)(xb + (size_t)row * DM + 8 * lane + 512 * j); }
#pragma unroll
        for (int t = 0; t < 2; ++t) { const int row = rb + t * ngw; if (row >= MT) break;
            const int cr = row < NPR ? 0 : 1 + ((row - NPR) >> 12);
            const float* md = mod + (size_t)cr * 6144; float ss = 0.f; f32x4 xa[4], xc[4];
#pragma unroll
            for (int j = 0; j < 4; ++j) { xa[j] = unp_lo(v[t][j]); xc[j] = unp_hi(v[t][j]); }
            if (pend && row >= PROW0) { const float* pr = pend + (size_t)(row - PROW0) * DM + 8 * lane;
#pragma unroll
                for (int j = 0; j < 4; ++j) { xa[j] += *(const f32x4*)(pr + 512 * j); xc[j] += *(const f32x4*)(pr + 512 * j + 4); *(v4u*)(xb + (size_t)row * DM + 8 * lane + 512 * j) = pack8(xa[j], xc[j]); } }
#pragma unroll
            for (int j = 0; j < 4; ++j)
                ss += (xa[j].x * xa[j].x + xa[j].y * xa[j].y) + (xa[j].z * xa[j].z + xa[j].w * xa[j].w) + (xc[j].x * xc[j].x + xc[j].y * xc[j].y) + (xc[j].z * xc[j].z + xc[j].w * xc[j].w);
            const float rstd = __builtin_amdgcn_rsqf(wave_sum(ss) * (1.f / DM) + EPS);
#pragma unroll
            for (int j = 0; j < 4; ++j) { const int c = 8 * lane + 512 * j;
                const f32x4 g0 = *(const f32x4*)(g + c), g1 = *(const f32x4*)(g + c + 4), s0 = *(const f32x4*)(md + c), s1 = *(const f32x4*)(md + c + 4), c0 = *(const f32x4*)(md + 2048 + c), c1 = *(const f32x4*)(md + 2048 + c + 4);
                *(v4u*)(H + (size_t)row * DM + c) = pack8(xa[j] * rstd * g0 * (c0 + 1.f) + s0, xc[j] * rstd * g1 * (c1 + 1.f) + s1); } }
    }
}
__device__ __forceinline__ void adaln_item(LAS unsigned char* lds, const float* __restrict__ c, const float* __restrict__ c_ctx, const float* __restrict__ w_ada, const float* __restrict__ b_ada, float* __restrict__ MOD, int item, int tid) {
    LAS float* sc = (LAS float*)lds;
#pragma unroll 6
    for (int i = tid; i < 9 * 2048; i += 512) { const int r = i >> 11, k = i & 2047; sc[i] = silu_f(r == 0 ? c_ctx[k] : c[(r - 1) * 2048 + k]); }
    __syncthreads();
    const int l = item / 24, cb = item - 24 * l, lane = tid & 63, w = tid >> 6;
    const float* W = w_ada + ((size_t)l * 2048 + w * 256) * 6144 + cb * 256 + lane * 4;
    f32x4 acc[9];
#pragma unroll
    for (int r = 0; r < 9; ++r) acc[r] = (f32x4){0.f, 0.f, 0.f, 0.f};
#pragma unroll 4
    for (int k = 0; k < 256; k += 4) {
        const f32x4 w0 = *(const f32x4*)(W + (size_t)(k + 0) * 6144), w1 = *(const f32x4*)(W + (size_t)(k + 1) * 6144), w2 = *(const f32x4*)(W + (size_t)(k + 2) * 6144), w3 = *(const f32x4*)(W + (size_t)(k + 3) * 6144);
#pragma unroll
        for (int r = 0; r < 9; ++r) { const f32x4 s = *(const LAS f32x4*)(sc + r * 2048 + w * 256 + k); acc[r] += w0 * s.x + w1 * s.y + w2 * s.z + w3 * s.w; }
    }
    __syncthreads();
    LAS float* red = (LAS float*)lds;
#pragma unroll
    for (int r = 0; r < 9; ++r) *(LAS f32x4*)(red + (w * 9 + r) * 256 + lane * 4) = acc[r];
    __syncthreads();
    for (int o = tid; o < 9 * 256; o += 512) { const int r = o >> 8, cc = o & 255; float s = b_ada[l * 6144 + cb * 256 + cc];
#pragma unroll
        for (int w2 = 0; w2 < 8; ++w2) s += red[(w2 * 9 + r) * 256 + cc];
        MOD[(size_t)(l * 9 + r) * 6144 + cb * 256 + cc] = s; }
    __syncthreads();
}
__device__ const double ROPE_CT[16] = {0.5403023058681398, 0.8460091102817079, 0.9504152802551828, 0.9842302344700946, 0.9950041652780258, 0.9984192777926645, 0.9995000416652778, 0.9998418902836144,
                                       0.9999500004166653, 0.9999841886533658, 0.9999950000041666, 0.9999984188615866, 0.9999995000000417, 0.9999998418861211, 0.9999999500000004, 0.9999999841886117};
__device__ const double ROPE_ST[16] = {0.8414709848078965, 0.5331684399140229, 0.31098359290718575, 0.17689218624615005, 0.09983341664682814, 0.056204499214692484, 0.03161750640243371, 0.01778185687966613,
                                       0.009999833334166664, 0.005623383613960186, 0.0031622723897082477, 0.0017782784728035289, 0.0009999998333333417, 0.0005623412955523593, 0.0003162277607463752, 0.00017782794006665676};
__device__ __forceinline__ void e3_norm_rows(const bf16* __restrict__ QA, const bf16* __restrict__ CKVR, const float* __restrict__ kvg, bf16* __restrict__ QN, bf16* __restrict__ CKV, float* __restrict__ nckv  ,
                                             int gw, int ngw, int lane) {
    const f32x4 g0 = *(const f32x4*)(kvg + 8 * lane), g1 = *(const f32x4*)(kvg + 8 * lane + 4);
    for (int rb = gw; rb < MT; rb += 4 * ngw) {
        v4u wq[4], wc[4];
#pragma unroll
        for (int t = 0; t < 4; ++t) { const int row = rb + t * ngw; if (row < MT) { wq[t] = *(const v4u*)(QA + (size_t)row * 512 + 8 * lane); wc[t] = *(const v4u*)(CKVR + (size_t)row * 512 + 8 * lane); } else { wq[t] = zero4(); wc[t] = wq[t]; } }
#pragma unroll
        for (int t = 0; t < 4; ++t) { const int row = rb + t * ngw; if (row >= MT) break;
            { const f32x4 a = unp_lo(wq[t]), b = unp_hi(wq[t]); const float ss = (a.x * a.x + a.y * a.y) + (a.z * a.z + a.w * a.w) + (b.x * b.x + b.y * b.y) + (b.z * b.z + b.w * b.w);
              const float rstd = __builtin_amdgcn_rsqf(wave_sum(ss) * (1.f / 512.f) + EPS);
              *(v4u*)(QN + (size_t)row * 512 + 8 * lane) = pack8(a * rstd, b * rstd); }
            { const f32x4 a = unp_lo(wc[t]), b = unp_hi(wc[t]); const float ss = (a.x * a.x + a.y * a.y) + (a.z * a.z + a.w * a.w) + (b.x * b.x + b.y * b.y) + (b.z * b.z + b.w * b.w);
              const float rstd = __builtin_amdgcn_rsqf(wave_sum(ss) * (1.f / 512.f) + EPS);
              const f32x4 y0 = a * rstd * g0, y1 = b * rstd * g1;
              *(v4u*)(CKV + (size_t)pg8::kvrow_of(row) * 512 + 8 * lane) = pack8(y0, y1);
              if (row < NPR) { float* op = nckv + (size_t)(row >> 8) * (2 * 256 * 512) + (row & 255) * 512 + 8 * lane; *(f32x4*)op = y0; *(f32x4*)(op + 4) = y1; } } }
    }
}
__device__ __forceinline__ void e3_cache_rows(const float* __restrict__ cckv  , const float* __restrict__ ckpe  ,
                                              bf16* __restrict__ CKV, bf16* __restrict__ KPE, int gw, int ngw, int lane) {
    for (int r = gw; r < 8 * 512; r += ngw) { const int b = r >> 9, j = r & 511; const size_t kvr = (size_t)NPR + (size_t)b * KVS + j;
        const float* sp = cckv + (size_t)b * (2 * 512 * 512) + (size_t)j * 512 + 8 * lane;
        *(v4u*)(CKV + kvr * 512 + 8 * lane) = pack8(*(const f32x4*)sp, *(const f32x4*)(sp + 4));
        if (lane < 8) { const float* kp = ckpe + (size_t)b * (2 * 512 * 64) + (size_t)j * 64 + 8 * lane; *(v4u*)(KPE + kvr * 64 + 8 * lane) = pack8(*(const f32x4*)kp, *(const f32x4*)(kp + 4)); } }
}
__device__ __forceinline__ void e3_conv_fix(const bf16* __restrict__ U1B, const bf16* __restrict__ PPB, const float* __restrict__ cw  , bf16* __restrict__ MIX, int gw, int ngw, int lane) {
    for (int k = gw; k < MT / 8; k += ngw) { const int g = k >> 1, top = k & 1, row = 16 * g + (top ? 15 : 0);
        const bool hp = row < NPR ? (row & 255) != 0 : ((row - NPR) & 4095) != 0, hn = row < NPR ? (row & 255) != 255 : ((row - NPR) & 4095) != 4095;
        const bf16* pu_ = U1B + (size_t)k * 2048; const bf16* p1_ = PPB + ((size_t)g * 4 + (top ? 3 : 0)) * 2048;
        const bf16* p0_ = top ? PPB + ((size_t)g * 4 + 2) * 2048 : PPB + ((size_t)(g - 1) * 4 + 3) * 2048;
        const bf16* p2_ = top ? PPB + ((size_t)(g + 1) * 4 + 0) * 2048 : PPB + ((size_t)g * 4 + 1) * 2048;
        const bool l0 = top || hp, l2 = !top || hn;
#pragma unroll
        for (int it = 0; it < 4; ++it) { const int c = 8 * lane + 512 * it;
            const v4u pu = *(const v4u*)(pu_ + c), p1 = *(const v4u*)(p1_ + c); v4u p0 = zero4(), p2 = zero4();
            if (l0) p0 = *(const v4u*)(p0_ + c); if (l2) p2 = *(const v4u*)(p2_ + c);
            const f32x4 w0a = *(const f32x4*)(cw + c), w0b = *(const f32x4*)(cw + c + 4), w1a = *(const f32x4*)(cw + 2048 + c), w1b = *(const f32x4*)(cw + 2048 + c + 4), w2a = *(const f32x4*)(cw + 4096 + c), w2b = *(const f32x4*)(cw + 4096 + c + 4);
            const f32x4 ya = unp_lo(pu) * (w0a * unp_lo(p0) + w1a * unp_lo(p1) + w2a * unp_lo(p2)), yb = unp_hi(pu) * (w0b * unp_hi(p0) + w1b * unp_hi(p1) + w2b * unp_hi(p2));
            *(v4u*)(MIX + (size_t)row * 4096 + c) = pack8(ya, yb); }
    }
}
__device__ __forceinline__ void final_rows(const bf16* __restrict__ xb, float* __restrict__ xo, const float* __restrict__ g, int gw, int ngw, int lane, const float* pend = nullptr) {
    for (int rb = gw; rb < MT; rb += 2 * ngw) { v4u v[2][4];
#pragma unroll
        for (int t = 0; t < 2; ++t) { const int row = rb + t * ngw < MT ? rb + t * ngw : rb;
#pragma unroll
            for (int j = 0; j < 4; ++j) v[t][j] = *(const v4u*)(xb + (size_t)row * DM + 8 * lane + 512 * j); }
#pragma unroll
        for (int t = 0; t < 2; ++t) { const int row = rb + t * ngw; if (row >= MT) break; float* xr = xo + (size_t)row * DM; float ss = 0.f; f32x4 xa[4], xc[4];
#pragma unroll
            for (int j = 0; j < 4; ++j) { xa[j] = unp_lo(v[t][j]); xc[j] = unp_hi(v[t][j]); }
            if (pend && row >= PROW0) { const float* pr = pend + (size_t)(row - PROW0) * DM + 8 * lane;
#pragma unroll
                for (int j = 0; j < 4; ++j) { xa[j] += *(const f32x4*)(pr + 512 * j); xc[j] += *(const f32x4*)(pr + 512 * j + 4); } }
#pragma unroll
            for (int j = 0; j < 4; ++j)
                ss += (xa[j].x * xa[j].x + xa[j].y * xa[j].y) + (xa[j].z * xa[j].z + xa[j].w * xa[j].w) + (xc[j].x * xc[j].x + xc[j].y * xc[j].y) + (xc[j].z * xc[j].z + xc[j].w * xc[j].w);
            const float rstd = __builtin_amdgcn_rsqf(wave_sum(ss) * (1.f / DM) + EPS);
#pragma unroll
            for (int j = 0; j < 4; ++j) { const int c = 8 * lane + 512 * j; *(f32x4*)(xr + c) = xa[j] * rstd * *(const f32x4*)(g + c); *(f32x4*)(xr + c + 4) = xc[j] * rstd * *(const f32x4*)(g + c + 4); } } }
}
__device__ __forceinline__ void sg_phase(LAS unsigned char* lds, int vcu, int G, const bf16* __restrict__ VR, const float* __restrict__ stats, const float* __restrict__ lng, const float* __restrict__ lnb,
                                         const bf16* __restrict__ WsB  , const float* __restrict__ bs  , bf16* __restrict__ UG) {
    int tid_ = threadIdx.x; asm volatile("" : "+v"(tid_));
    const int tid = tid_, wid = __builtin_amdgcn_readfirstlane(tid >> 6), lane = tid & 63, r32 = lane & 31, hi = lane >> 5;
    constexpr int NUNITS = 288 * 8;
    if (vcu >= NUNITS) return;
    const int nU = (NUNITS - vcu + G - 1) / G, nS = 2 * nU;
    LAS f32x2* ST = (LAS f32x2*)(lds + 65536);
    for (int r = tid; r < nU * 128; r += 512) { const int c = (vcu + (r >> 7) * G) >> 3; const f32x4* sp = (const f32x4*)(stats + (size_t)(c * 128 + (r & 127)) * 128); float s = 0.f, q = 0.f;
#pragma unroll 16
        for (int k = 0; k < 32; ++k) { const f32x4 v = sp[k]; s += v.x + v.z; q += v.y + v.w; }
        const float mean = s * (1.f / 4096.f), var = q * (1.f / 4096.f) - mean * mean; ST[r] = (f32x2){mean, __builtin_amdgcn_rsqf(var + EPS)}; }
    const int pb = wid & 3, dh = wid >> 2, q0 = tid >> 5, d = 8 * (tid & 31);
    v4u vr[8];
#define SG_LOAD_VR(s_) do { const int sn_ = (s_), un_ = vcu + (sn_ >> 1) * G; const bf16* vp_ = VR + (size_t)((un_ >> 3) * 128 + q0) * 4096 + (2 * (un_ & 7) + (sn_ & 1)) * 256 + d; \
        _Pragma("unroll") for (int k = 0; k < 8; ++k) vr[k] = *(const v4u*)(vp_ + (size_t)k * 16 * 4096); } while (0)
    SG_LOAD_VR(0);
    __syncthreads();
    for (int s = 0; s < nS; ++s) {
        const int u = vcu + (s >> 1) * G, c = u >> 3, g = 2 * (u & 7) + (s & 1), r0 = 128 * c;
        { const float* gp = lng + g * 256 + d; const float* bp = lnb + g * 256 + d; const f32x4 ga = *(const f32x4*)gp, gb = *(const f32x4*)(gp + 4), ba = *(const f32x4*)bp, bb = *(const f32x4*)(bp + 4);
#pragma unroll
          for (int k = 0; k < 8; ++k) { const int q = q0 + 16 * k; const f32x2 st = ST[(s >> 1) * 128 + q]; const v4u w = vr[k];
            const f32x4 ya = (unp_lo(w) - st.x) * st.y * ga + ba, yb = (unp_hi(w) - st.x) * st.y * gb + bb;
            *(LAS v4u*)(lds + ((q >> 6) * 2 + (d >> 7)) * 16384 + att::v_st(q & 63, d & 127)) = pack8(ya, yb); } }
        v4u ug[8]; bf16* up = UG + (size_t)(r0 + q0) * 4096 + g * 256 + d;
#pragma unroll
        for (int k = 0; k < 8; ++k) ug[k] = *(const v4u*)(up + (size_t)k * 16 * 4096);
        if (s + 1 < nS) SG_LOAD_VR(s + 1);
        bf16x8 afr[8];
        { const bf16* ap = WsB + ((size_t)(g * 128 + 32 * pb + r32)) * 128 + 8 * hi;
#pragma unroll
          for (int t = 0; t < 8; ++t) afr[t] = *(const bf16x8*)(ap + 16 * t); }
        float bsv[16];
#pragma unroll
        for (int r = 0; r < 16; ++r) bsv[r] = bs[g * 128 + 32 * pb + att::crow(r, hi)];
        __syncthreads();
        f32x16 od[4] = {};
#pragma unroll
        for (int qh = 0; qh < 2; ++qh) { const int vb = (int)(unsigned)(uintptr_t)(lds + (qh * 2 + dh) * 16384) + att::v_rd_base(lane);
            att::pv_d0(od, vb, afr[4 * qh + 0], afr[4 * qh + 1], afr[4 * qh + 2], afr[4 * qh + 3]); }
        __syncthreads();
#pragma unroll
        for (int r = 0; r < 16; ++r) { const int p = 32 * pb + att::crow(r, hi);
#pragma unroll
            for (int d0 = 0; d0 < 4; ++d0) *(LAS bf16*)(lds + p * 512 + (dh * 128 + d0 * 32 + r32) * 2) = (bf16)(cvt_pk_bf16(od[d0][r] + bsv[r], 0.f) & 0xffffu); }
        __syncthreads();
#pragma unroll
        for (int k = 0; k < 8; ++k) { const v4u a = *(const LAS v4u*)(lds + (q0 + 16 * k) * 512 + 2 * d), w = ug[k];
            v4u o; o.x = cvt_pk_bf16(bflo(a.x) * bflo(w.x), bfhi(a.x) * bfhi(w.x)); o.y = cvt_pk_bf16(bflo(a.y) * bflo(w.y), bfhi(a.y) * bfhi(w.y));
            o.z = cvt_pk_bf16(bflo(a.z) * bflo(w.z), bfhi(a.z) * bfhi(w.z)); o.w = cvt_pk_bf16(bflo(a.w) * bflo(w.w), bfhi(a.w) * bfhi(w.w));
            *(v4u*)(up + (size_t)k * 16 * 4096) = o; }
        __syncthreads();
    }
#undef SG_LOAD_VR
}

__device__ __forceinline__ void convert_even(const float* w_in, const float* w_qb, const float* w_kvb, const float* w_out, const float* qg, bf16* WEIN, bf16* WEQB, bf16* WEKVB, bf16* WEOUT, LAS float* scr, int w, int nw, int lane) {
    constexpr int I_IN = 32 * (EVEN_IN / 32), I_QB = 8 * 96, I_KVB = 8 * 128, I_OUT = 64 * 64;
    for (int it = w; it < I_IN + I_QB + I_KVB + I_OUT; it += nw) { int r = it;
        if (r < I_IN) { cvt_item(w_in, 2048, EVEN_IN, WEIN, DestEvenIn{}, (const float*)nullptr, scr, r, lane); continue; } r -= I_IN;
        if (r < I_QB) { cvt_item(w_qb, 512, 3072, WEQB, DestQb{}, qg, scr, r, lane); continue; } r -= I_QB;
        if (r < I_KVB) { cvt_item(w_kvb, 512, 4096, WEKVB, DestP32{}, (const float*)nullptr, scr, r, lane); continue; } r -= I_KVB;
        cvt_item(w_out, 4096, 2048, WEOUT, DestP32{}, (const float*)nullptr, scr, r, lane); }
    for (int q = w * 64 + lane; q < 192 * 2048 / 8; q += nw * 64) *(v4u*)(WEIN + (size_t)9280 * 2048 + (size_t)q * 8) = zero4();
}
__device__ __forceinline__ void convert_odd(const float* w_in, const float* w_out, const float* wsrc, bf16* WOIN, bf16* WOOUT, bf16* WOS, LAS float* scr, int w, int nw, int lane) {
    constexpr int I_IN = 32 * (ODD_IN / 32), I_OUT = 64 * 64;
    for (int it = w; it < I_IN + I_OUT; it += nw) { int r = it;
        if (r < I_IN) { cvt_item(w_in, 2048, ODD_IN, WOIN, DestOddIn{}, (const float*)nullptr, scr, r, lane); continue; } r -= I_IN;
        cvt_item(w_out, 4096, 2048, WOOUT, DestP32{}, (const float*)nullptr, scr, r, lane); }
    for (int q = w * 64 + lane; q < 16 * 128 * 128 / 8; q += nw * 64) *(v4u*)(WOS + (size_t)q * 8) = pack8(*(const f32x4*)(wsrc + (size_t)q * 8), *(const f32x4*)(wsrc + (size_t)q * 8 + 4));
}

constexpr int NPH = 26;
#ifndef MK_N_LAUNCHES
#define MK_N_LAUNCHES 1
#endif
struct Args { const float* in[23]; float* out; unsigned char* ws; int ph_lo, ph_hi; };
__global__ void __launch_bounds__(512, 2) fwd(Args args) {
    extern __shared__ __attribute__((aligned(16))) unsigned char lds_raw[];
    LAS unsigned char* lds = (LAS unsigned char*)lds_raw;
    volatile LAS unsigned* MISC = (volatile LAS unsigned*)(lds + MISC_OFF);
    const int tid0 = threadIdx.x, lane0 = tid0 & 63, wave = __builtin_amdgcn_readfirstlane(tid0 >> 6);
    const int G0 = gridDim.x, bx0 = blockIdx.x, vcu0 = (G0 % 8 == 0) ? (bx0 % 8) * (G0 / 8) + bx0 / 8 : bx0;
    for (int u = tid0; u < (LDS_BYTES - LDSCTL_OFF) / 4; u += 512) ((LAS unsigned*)(lds + LDSCTL_OFF))[u] = 0u;
    __syncthreads();
    XcdBarrier bar = xcd_barrier_post((unsigned*)(args.ws + WS_CTL) + CW_BAR, MISC + 8);
    const int lo = args.ph_lo, hi = args.ph_hi; (void)lo; (void)hi;
#ifndef PH_MASK
#define PH_MASK 0xFFFF
#endif
#define EN(b) (((PH_MASK) >> (b)) & 1)
#ifndef PROBE_DUP
#define PROBE_DUP 0
#endif
#define REPS(b) for (int rep_ = 0; rep_ < ((((PROBE_DUP) >> (b)) & 1) ? 2 : 1); ++rep_)
#if MK_N_LAUNCHES == 1
#define IN(k) true
#else
#define IN(k) (lo <= (k) && (k) < hi)
#endif
#define SEAM(k) do { if (IN((k) + 1)) { XcdBarrier b_ = bar; asm volatile("" : "+s"(b_.bar), "+s"(b_.x)); xcd_barrier(b_); } } while (0)
#define PHASE_Z() int z_ = 0; asm volatile("; phase" : "+s"(z_)); unsigned char* ws = args.ws + z_; int lane = lane0; asm volatile("" : "+v"(lane)); const int tid = wave * 64 + lane; \
    int G = G0, bx = bx0, vcu = vcu0; asm volatile("" : "+s"(G), "+s"(bx), "+s"(vcu)); const int gw = vcu * 8 + wave, ngw = G * 8; (void)tid; (void)gw; (void)ngw; (void)bx
#define INP(k) (args.in[(k) + z_])
#define XO ((float*)args.out + z_)
#define NEW_CKV (XO + (size_t)MT * DM)
#define NEW_KPE (NEW_CKV + (size_t)16 * 2 * 256 * 512)
#define MOD ((float*)(ws + WS_MOD))
#define ROPE ((float*)(ws + WS_ROPE))
#define WSP(off) ((bf16*)(ws + (off)))
#define CONVERT_EVEN(ii, w_, nw_) convert_even(INP(9) + (size_t)(ii) * 2048 * EVEN_IN, INP(12) + (size_t)(ii) * 512 * 3072, INP(14) + (size_t)(ii) * 512 * 4096, INP(15) + (size_t)(ii) * 4096 * 2048, INP(11) + (ii) * 512, \
        WSP(WE_IN), WSP(WE_QB), WSP(WE_KVB), WSP(WE_OUT), scr, (w_), (nw_), lane)
#define CONVERT_ODD(ii, w_, nw_) convert_odd(INP(16) + (size_t)(ii) * 2048 * ODD_IN, INP(21) + (size_t)(ii) * 4096 * 2048, INP(19) + (size_t)(ii) * 16 * 128 * 128, WSP(WO_IN), WSP(WO_OUT), WSP(WO_S), scr, (w_), (nw_), lane)
#define TAIL_WORKERS() const int R_ = 1152 % G, cw_ = R_ ? bx - R_ : bx, ncw_ = R_ ? G - R_ : G
    LAS float* scr = (LAS float*)(lds + wave * 16384);

    if (EN(0) && IN(0)) { PHASE_Z();
        for (int it = bx; it < 96; it += G) adaln_item(lds, INP(4), INP(5), INP(7), INP(8), MOD, it, tid);
        { const int cw_ = G > 96 ? bx - 96 : bx, ncw_ = G > 96 ? G - 96 : G; if (cw_ >= 0) CONVERT_EVEN(0, cw_ * 8 + wave, ncw_ * 8); }
        if (bx == G - 1 && tid < 16) { const double ct = ROPE_CT[tid], st = ROPE_ST[tid]; double cc = 1.0, ss = 0.0; float* rope = ROPE;
            for (int pos = 0; pos < 64; ++pos) { rope[(pos * 16 + tid) * 2] = (float)cc; rope[(pos * 16 + tid) * 2 + 1] = (float)ss; const double nc = cc * ct - ss * st; ss = ss * ct + cc * st; cc = nc; } }
        SEAM(0);
    }
    for (int lp = 0; lp < 2; ++lp) {
        const int pb = 1 + 12 * lp, i = lp;
        { const int l = 2 * lp;
        if (EN(1) && IN(pb + 0)) { PHASE_Z();
            REPS(1) {
            if (l == 0) modnorm_rows(INP(0), INP(1), XO, 1, INP(6) + (size_t)l * DM, MOD + (size_t)l * 9 * 6144, WSP(WS_HE), gw, ngw, lane);
            else modnorm_rows_bf(WSP(WS_XB), INP(6) + (size_t)l * DM, MOD + (size_t)l * 9 * 6144, WSP(WS_HE), gw, ngw, lane);
            }
            SEAM(pb + 0);
        }
        if (EN(2) && IN(pb + 1)) { PHASE_Z();
            REPS(2) {
            pg8::Gemm g{WSP(WS_HE), WSP(WE_IN), MT, EVEN_NV, 2048}; pg8::StaticOrder S; S.init(MT, EVEN_NV, G, bx);
            pg8::EpiEvenIn E{WSP(WS_MIX), WSP(WS_PPB), WSP(WS_U1B), WSP(WS_QA), WSP(WS_CKVR), WSP(WS_KPE), NEW_KPE + (size_t)i * 256 * 64, ROPE, INP(10) + (size_t)i * 3 * 2048};
            pg8::gemm_phase<pg8::EpiEvenIn, pg8::StaticOrder, true, true>(lds, g, S, E);
            }
            if (G == 256) { const int R_ = ((MT / 256) * (EVEN_NV / 256)) % G, cw_ = R_ ? bx - R_ : -1, ncw_ = G - R_; if (cw_ >= 0) CONVERT_ODD(i, cw_ * 8 + wave, ncw_ * 8); }
            SEAM(pb + 1);
        }
        if (EN(3) && IN(pb + 2)) { PHASE_Z();
            REPS(3) {
            e3_norm_rows(WSP(WS_QA), WSP(WS_CKVR), INP(13) + i * 512, WSP(WS_QN), WSP(WS_CKV), NEW_CKV + (size_t)i * 256 * 512, gw, ngw, lane);
            e3_cache_rows(INP(2) + (size_t)i * 512 * 512, INP(3) + (size_t)i * 512 * 64, WSP(WS_CKV), WSP(WS_KPE), gw, ngw, lane);
            e3_conv_fix(WSP(WS_U1B), WSP(WS_PPB), INP(10) + (size_t)i * 3 * 2048, WSP(WS_MIX), gw, ngw, lane);
            }
            SEAM(pb + 2);
        }
        for (int hg = 0; hg < 2; ++hg) {
            if (EN(4) && IN(pb + 3 + 2 * hg)) { PHASE_Z();
            REPS(4) {
                { pg8::Gemm g{WSP(WS_QN), WSP(WE_QB) + (size_t)hg * 1536 * 512, MT, 1536, 512}; pg8::StaticOrder S; S.init(MT, 1536, G, bx); pg8::EpiQ E{WSP(WS_Q), ROPE};
                  pg8::gemm_phase<pg8::EpiQ, pg8::StaticOrder, true, true>(lds, g, S, E); }
                { pg8::Gemm g{WSP(WS_CKV), WSP(WE_KVB) + (size_t)hg * 2048 * 512, KVR, 2048, 512}; pg8::StaticOrder S; S.init(KVR, 2048, G, bx); pg8::EpiStore E{WSP(WS_KV), 2048};
                  pg8::gemm_phase<pg8::EpiStore, pg8::StaticOrder, true, true>(lds, g, S, E); }
            }
                SEAM(pb + 3 + 2 * hg);
            }
            if (EN(5) && IN(pb + 4 + 2 * hg)) { PHASE_Z();
            REPS(5) {
                const bf16* Qb = WSP(WS_Q); const unsigned char* KVb = ws + WS_KV; const unsigned char* KPEb = ws + WS_KPE; bf16* MIX = WSP(WS_MIX);
                for (int u = vcu; u < 1152; u += G) {
                    int b, hl, qrow0, kvrow0, NT;
                    if (u < 1024) { b = u >> 7; hl = (u >> 4) & 7; qrow0 = NPR + b * 4096 + (u & 15) * 256; kvrow0 = NPR + b * KVS; NT = 72; }
                    else { const int v = u - 1024; b = v >> 3; hl = v & 7; qrow0 = b * 256; kvrow0 = b * 256; NT = 4; }
                    const int h = hg * 8 + hl; const unsigned char* kvp = KVb + ((size_t)kvrow0 * 2048 + hl * 256) * 2;
                    att::unit(lds, Qb + (size_t)qrow0 * 1536 + hl * 192, 1536, kvp, kvp + 256, KPEb + (size_t)kvrow0 * 128, NT,
                              MIX + (size_t)qrow0 * 4096 + 2048 + h * 128, 4096, MIX + (size_t)qrow0 * 4096 + 2048 + h * 128, 4096);
                }
            }
                SEAM(pb + 4 + 2 * hg);
            }
        }
        if (EN(6) && IN(pb + 7)) { PHASE_Z();
            pg8::Gemm g{WSP(WS_MIX), WSP(WE_OUT), MT, 2048, 4096}; pg8::TailSplitOrder S; S.init(MT, 2048, G, bx, true);
            pg8::EpiResid E{INP(0), INP(1), WSP(WS_XB), XO, MOD + (size_t)l * 9 * 6144 + 4096, l == 0 ? 1 : 0, 0, (float*)(ws + WS_PEND_E)};
            pg8::gemm_phase<pg8::EpiResid, pg8::TailSplitOrder, true, true, true>(lds, g, S, E);
            if (!S.split) { TAIL_WORKERS(); if (cw_ >= 0) CONVERT_ODD(i, cw_ * 8 + wave, ncw_ * 8); }
            SEAM(pb + 7);
        }
        }
        { const int l = 2 * lp + 1;
        if (EN(7) && IN(pb + 8)) { PHASE_Z();
            REPS(7) {
            modnorm_rows_bf(WSP(WS_XB), INP(6) + (size_t)l * DM, MOD + (size_t)l * 9 * 6144, WSP(WS_HO), gw, ngw, lane, G == 256 ? (const float*)(ws + WS_PEND_E) : nullptr);
            }
            SEAM(pb + 8);
        }
        if (EN(8) && IN(pb + 9)) { PHASE_Z();
            REPS(8) {
            pg8::Gemm g{WSP(WS_HO), WSP(WO_IN), MT, ODD_IN, 2048}; pg8::StaticOrder S; S.init(MT, ODD_IN, G, bx);
            pg8::EpiOddIn E{WSP(WS_UG), WSP(WS_VR), (float*)(ws + WS_STATS)};
            pg8::gemm_phase<pg8::EpiOddIn, pg8::StaticOrder, true, true>(lds, g, S, E);
            }
            SEAM(pb + 9);
        }
        if (EN(9) && IN(pb + 10)) { PHASE_Z();
            sg_phase(lds, vcu, G, WSP(WS_VR), (const float*)(ws + WS_STATS), INP(17) + (size_t)i * 4096, INP(18) + (size_t)i * 4096, WSP(WO_S), INP(20) + (size_t)i * 16 * 128, WSP(WS_UG));
            SEAM(pb + 10);
        }
        if (EN(10) && IN(pb + 11)) { PHASE_Z();
            pg8::Gemm g{WSP(WS_UG), WSP(WO_OUT), MT, 2048, 4096}; pg8::TailSplitOrder S; S.init(MT, 2048, G, bx, lp + 1 == 2);
            pg8::EpiResid E{INP(0), INP(1), WSP(WS_XB), XO, MOD + (size_t)l * 9 * 6144 + 4096, 0, 0, (float*)(ws + WS_PEND_O)};
            pg8::gemm_phase<pg8::EpiResid, pg8::TailSplitOrder, true, true, true>(lds, g, S, E);
            if (lp + 1 < 2) { TAIL_WORKERS(); if (cw_ >= 0) CONVERT_EVEN(i + 1, cw_ * 8 + wave, ncw_ * 8); }
            SEAM(pb + 11);
        }
        }
    }
    if (EN(11) && IN(25)) { PHASE_Z(); final_rows(WSP(WS_XB), XO, INP(22), gw, ngw, lane, G == 256 ? (const float*)(ws + WS_PEND_O) : nullptr); }
#undef IN
#undef SEAM
}

extern "C" void kernel_launch(void* const* d_in, const int* in_sizes, int n_in, void* d_out, int out_size, void* d_ws, size_t ws_size, hipStream_t stream) {
    static int grid = 0;
    if (grid == 0) {
        if (n_in != 23 || in_sizes[0] != NPR * DM || in_sizes[1] != NSM * DM || out_size != MT * DM + 16 * 2 * 256 * 512 + 16 * 2 * 256 * 64 || ws_size < WS_END) {
            fprintf(stderr, "kernel_launch: shape mismatch (n_in %d, out %d, ws %zu, need %zu); nothing launched\n", n_in, out_size, ws_size, (size_t)WS_END); grid = -1; return; }
        int dev = 0, cus = 0, per_cu = 0;
        if (hipGetDevice(&dev) != hipSuccess || hipDeviceGetAttribute(&cus, hipDeviceAttributeMultiprocessorCount, dev) != hipSuccess) { grid = -1; return; }
        if (hipFuncSetAttribute((const void*)fwd, hipFuncAttributeMaxDynamicSharedMemorySize, LDS_BYTES) != hipSuccess) { fprintf(stderr, "kernel_launch: hipFuncSetAttribute failed\n"); grid = -1; return; }
        if (hipOccupancyMaxActiveBlocksPerMultiprocessor(&per_cu, (const void*)fwd, 512, LDS_BYTES) != hipSuccess || per_cu < 1) fprintf(stderr, "kernel_launch: occupancy query reports %d\n", per_cu);
        (void)hipGetLastError();
        grid = cus;
    }
    if (grid < 0) return;
    if (hipMemsetAsync((char*)d_ws + WS_CTL, 0, CTL_ZERO_BYTES, stream) != hipSuccess) return;
    Args a{};
    for (int i = 0; i < 23; ++i) a.in[i] = (const float*)d_in[i];
    a.out = (float*)d_out; a.ws = (unsigned char*)d_ws;
#if MK_N_LAUNCHES == 1
    a.ph_lo = 0; a.ph_hi = NPH;
    hipLaunchKernelGGL(fwd, dim3(grid), dim3(512), LDS_BYTES, stream, a);
#else
    for (int k = 0; k < NPH; ++k) { a.ph_lo = k; a.ph_hi = k + 1; hipLaunchKernelGGL(fwd, dim3(grid), dim3(512), LDS_BYTES, stream, a); }
#endif
    const hipError_t le = hipPeekAtLastError();
    if (le != hipSuccess) fprintf(stderr, "kernel_launch: launch failed: %s\n", hipGetErrorName(le));
}
```

```cpp
#include <hip/hip_runtime.h>
#include <cstdio>
#include <cstdint>
namespace pg8 {
#define PG8_LAS __attribute__((address_space(3)))
typedef unsigned short bf16_t;
typedef short bf16x8 __attribute__((ext_vector_type(8)));
typedef float f32x4 __attribute__((ext_vector_type(4)));
typedef unsigned u32x4 __attribute__((ext_vector_type(4)));
constexpr int BM = 256, BK = 64, HALF = 128, HTB = HALF * BK * 2  , STAGE_BYTES = 8 * HTB, NXCD = 8, WGM = 8;

__host__ __device__ __forceinline__ int lds_byte(int r, int c) { const int st = (r >> 4) * 2 + (c >> 5), rr = r & 15, cc = c & 31, ob = rr * 64 + cc * 2; return st * 1024 + (ob ^ (((ob >> 9) & 1) << 5)); }
__host__ __device__ __forceinline__ void stage_rc(int b, int& R, int& C) { const int st = b / 1024, sb = b % 1024, swz = sb ^ (((sb >> 9) & 1) << 5); R = (st >> 1) * 16 + swz / 64; C = (st & 1) * 32 + (swz % 64) / 2; }
__host__ __device__ __forceinline__ int perm32(int rho) { const int n = rho >> 4, i = rho & 15; return 8 * (i >> 2) + 4 * n + (i & 3); }

struct Unit { int pm, pn, kh; };
struct Gemm { const bf16_t* A; const bf16_t* Bt; int M, N, K; };

struct StaticOrder {
    int nM, nN, nwg, G, c; unsigned q8, r8, nig, mnig;
    __host__ __device__ void init(int M, int N, int G_, int c_) { nM = M / BM; nN = N / BM; nwg = nM * nN; G = G_; c = c_; q8 = (unsigned)nwg / NXCD; r8 = (unsigned)nwg % NXCD; nig = (unsigned)(WGM * nN);
        mnig = (unsigned)((0x100000000ull + nig - 1) / nig); }
    __host__ __device__ bool next(int i, Unit& u) const {
        const unsigned L = (unsigned)i * (unsigned)G + (unsigned)c; if (L >= (unsigned)nwg) return false;
        const unsigned xcd = L & 7u, off = L >> 3; const unsigned wgid = (xcd < r8 ? xcd * (q8 + 1u) : r8 * (q8 + 1u) + (xcd - r8) * q8) + off;
        const unsigned gid = (unsigned)(((unsigned long long)wgid * mnig) >> 32), rem = wgid - gid * nig;
        u.pm = (int)(gid * WGM + (rem & (WGM - 1))); u.pn = (int)(rem / WGM); u.kh = 0; return true;
    }
    __device__ __forceinline__ void a_ready(const Unit&) const {}
    __device__ __forceinline__ void done(const Unit&) const {}
};
struct TailSplitOrder {
    StaticOrder s; int c; bool split;
    __host__ __device__ void init(int M, int N, int G_, int c_, bool enable) { split = enable && G_ == 256 && M == 144 * BM && N == 8 * BM; c = c_; s.init(split ? 128 * BM : M, N, G_, c_); }
    __host__ __device__ bool next(int i, Unit& u) const {
        if (!split || i < 4) return s.next(i, u);
        if (i > 4) return false;
        const int t = c & 127, x = t & 7, j = t >> 3; u.pm = 128 + 2 * x + (j & 1); u.pn = j >> 1; u.kh = 1 + (c >> 7); return true;
    }
    __device__ __forceinline__ void a_ready(const Unit&) const {}
    __device__ __forceinline__ void done(const Unit&) const {}
};

__device__ __forceinline__ unsigned cvt_pk_bf16(float lo, float hi) { unsigned r; asm volatile("v_cvt_pk_bf16_f32 %0, %1, %2" : "=v"(r) : "v"(lo), "v"(hi)); return r; }
typedef float f32x2 __attribute__((ext_vector_type(2)));
template <class Epi, class Sched, bool ALIGN_EPI = false, bool SP2 = false, bool KSPLIT = false>
__device__ __forceinline__ void gemm_phase(PG8_LAS unsigned char* lds, const Gemm g, const Sched& S, const Epi& E) {
    int tid_ = threadIdx.x; asm volatile("" : "+v"(tid_));
    const int tid = tid_, wid = __builtin_amdgcn_readfirstlane(tid >> 6), lane = tid & 63, wr = wid >> 2, wc = wid & 3, fr = lane & 15, fq = lane >> 4;
    const int K = g.K, nt = K / BK;
    unsigned voffA[2], voffB[2];
#pragma unroll
    for (int i = 0; i < 2; ++i) { int R, C; stage_rc(tid * 16 + i * 8192, R, C); const int Rb = Epi::PERM ? ((R & ~31) + perm32(R & 31)) : R;
        voffA[i] = (unsigned)(R * K + C) * 2u; voffB[i] = (unsigned)(Rb * K + C) * 2u; }
    const size_t kstep = (size_t)(BK * 2);
    const size_t hstep = (size_t)HALF * K * 2;
    const size_t tstep = 2 * hstep;
    const unsigned ldsw = (unsigned)wid * 1024u;
    const int aoff = lds_byte(wr * 64 + fr, fq * 8), boff = lds_byte(wc * 32 + fr, fq * 8);
#define PG8_SA(b, h) (((b) * 2 + (h)) * HTB)
#define PG8_SB(b, h) ((4 + (b) * 2 + (h)) * HTB)
#define PG8_STAGE(bufoff, gbase, voff) do { _Pragma("unroll") for (int _i = 0; _i < 2; ++_i) \
        __builtin_amdgcn_global_load_lds((const unsigned*)((const char*)(gbase) + (voff)[_i]), (PG8_LAS unsigned*)(lds + (bufoff) + ldsw + _i * 8192), 16, 0, 0); } while (0)
#define PG8_LDA(dst, b, h) do { _Pragma("unroll") for (int m = 0; m < 4; ++m) _Pragma("unroll") for (int k = 0; k < 2; ++k) dst[m][k] = *(const PG8_LAS bf16x8*)(lds + PG8_SA(b, h) + aoff + m * 2048 + k * 1024); } while (0)
#define PG8_LDB(dst, b, h) do { _Pragma("unroll") for (int n = 0; n < 2; ++n) _Pragma("unroll") for (int k = 0; k < 2; ++k) dst[n][k] = *(const PG8_LAS bf16x8*)(lds + PG8_SB(b, h) + boff + n * 2048 + k * 1024); } while (0)
#define PG8_MMA(ai, bj, At, Bt) do { __builtin_amdgcn_s_setprio(1); _Pragma("unroll") for (int m = 0; m < 4; ++m) _Pragma("unroll") for (int n = 0; n < 2; ++n) _Pragma("unroll") for (int k = 0; k < 2; ++k) \
        acc[ai][bj][m][n] = __builtin_amdgcn_mfma_f32_16x16x32_bf16(Bt[n][k], At[m][k], acc[ai][bj][m][n], 0, 0, 0); __builtin_amdgcn_s_setprio(0); } while (0)
#define PG8_WAIT_V(n) asm volatile("s_waitcnt vmcnt(" #n ")" ::: "memory")
#define PG8_WAIT_L(n) asm volatile("s_waitcnt lgkmcnt(" #n ")" ::: "memory")
#define PG8_BAR __builtin_amdgcn_s_barrier()
#define PG8_SCHED __builtin_amdgcn_sched_barrier(0)
    Unit cur, nxt; int ui = 0;
    if (!S.next(0, cur)) return;
    f32x4 acc[2][2][4][2];
#pragma unroll
    for (int a = 0; a < 2; ++a)
#pragma unroll
        for (int b = 0; b < 2; ++b)
#pragma unroll
            for (int m = 0; m < 4; ++m)
#pragma unroll
                for (int n = 0; n < 2; ++n) acc[a][b][m][n] = (f32x4){0.f, 0.f, 0.f, 0.f};
    bf16x8 At[4][2], B0[2][2], B1[2][2];
    const size_t k2 = (size_t)K;
    const char* cA = (const char*)g.A + (size_t)cur.pm * tstep + (KSPLIT && cur.kh == 2 ? k2 : 0); const char* cB = (const char*)g.Bt + (size_t)cur.pn * tstep + (KSPLIT && cur.kh == 2 ? k2 : 0);
    S.a_ready(cur);
    if constexpr (SP2) {
        PG8_STAGE(PG8_SB(0, 0), cB, voffB); PG8_STAGE(PG8_SB(0, 1), cB + hstep, voffB); PG8_STAGE(PG8_SA(0, 0), cA, voffA); PG8_STAGE(PG8_SA(0, 1), cA + hstep, voffA);
        if (wr == 1) PG8_BAR;
        PG8_WAIT_V(2); PG8_BAR;
        PG8_STAGE(PG8_SB(1, 0), cB + kstep, voffB); PG8_STAGE(PG8_SA(1, 0), cA + kstep, voffA); PG8_STAGE(PG8_SB(1, 1), cB + hstep + kstep, voffB);
        PG8_WAIT_V(6); PG8_BAR;
    } else {
        PG8_STAGE(PG8_SB(0, 0), cB, voffB); PG8_STAGE(PG8_SA(0, 0), cA, voffA); PG8_STAGE(PG8_SB(0, 1), cB + hstep, voffB); PG8_STAGE(PG8_SA(0, 1), cA + hstep, voffA);
        if (wr == 1) PG8_BAR;
        PG8_WAIT_V(4); PG8_BAR;
        PG8_STAGE(PG8_SB(1, 0), cB + kstep, voffB); PG8_STAGE(PG8_SA(1, 0), cA + kstep, voffA); PG8_STAGE(PG8_SB(1, 1), cB + hstep + kstep, voffB);
        PG8_WAIT_V(6); PG8_BAR;
    }
    for (;;) {
        const bool has_next = S.next(ui + 1, nxt);
        const size_t nk = (KSPLIT && has_next && nxt.kh == 2) ? k2 : 0;
        const char* nA = has_next ? (const char*)g.A + (size_t)nxt.pm * tstep + nk : cA; const char* nB = has_next ? (const char*)g.Bt + (size_t)nxt.pn * tstep + nk : cB;
        const int ntu = (KSPLIT && cur.kh) ? (nt >> 1) : nt;
        for (int t = 0; t < ntu; t += 2) {
            const bool last = (t == ntu - 2);
            const char* a1 = cA + (size_t)(t + 1) * kstep;
            const char* a2 = last ? nA : cA + (size_t)(t + 2) * kstep; const char* b2 = last ? nB : cB + (size_t)(t + 2) * kstep;
            const char* a3 = a2 + kstep; const char* b3 = b2 + kstep;
            if (last && has_next) S.a_ready(nxt);
            if constexpr (SP2) {
            PG8_LDB(B0, 0, 0); PG8_LDB(B1, 0, 1); PG8_SCHED; PG8_LDA(At, 0, 0); PG8_STAGE(PG8_SA(1, 1), a1 + hstep, voffA);
            PG8_WAIT_V(8); PG8_WAIT_L(0); PG8_BAR; PG8_MMA(0, 0, At, B0); PG8_MMA(0, 1, At, B1); PG8_BAR; PG8_SCHED;
            PG8_LDA(At, 0, 1); PG8_STAGE(PG8_SB(0, 0), b2, voffB); PG8_STAGE(PG8_SB(0, 1), b2 + hstep, voffB); PG8_STAGE(PG8_SA(0, 0), a2, voffA);
            PG8_WAIT_V(8); PG8_WAIT_L(0); PG8_BAR; PG8_MMA(1, 0, At, B0); PG8_MMA(1, 1, At, B1); PG8_BAR; PG8_SCHED;
            PG8_LDB(B0, 1, 0); PG8_LDB(B1, 1, 1); PG8_SCHED; PG8_LDA(At, 1, 0); PG8_STAGE(PG8_SA(0, 1), a2 + hstep, voffA);
            PG8_WAIT_V(8); PG8_WAIT_L(0); PG8_BAR; PG8_MMA(0, 0, At, B0); PG8_MMA(0, 1, At, B1); PG8_BAR; PG8_SCHED;
            PG8_LDA(At, 1, 1); PG8_STAGE(PG8_SB(1, 0), b3, voffB); PG8_STAGE(PG8_SB(1, 1), b3 + hstep, voffB); PG8_STAGE(PG8_SA(1, 0), a3, voffA);
            PG8_WAIT_V(8); PG8_WAIT_L(0); PG8_BAR; PG8_MMA(1, 0, At, B0); PG8_MMA(1, 1, At, B1); PG8_BAR; PG8_SCHED;
            } else {
            PG8_LDB(B0, 0, 0); PG8_SCHED; PG8_LDA(At, 0, 0); PG8_STAGE(PG8_SA(1, 1), a1 + hstep, voffA);
            PG8_WAIT_L(8); PG8_BAR; PG8_WAIT_L(0); PG8_MMA(0, 0, At, B0); PG8_BAR; PG8_SCHED;
            PG8_LDB(B1, 0, 1); PG8_STAGE(PG8_SB(0, 0), b2, voffB);
            PG8_BAR; PG8_WAIT_L(0); PG8_MMA(0, 1, At, B1); PG8_BAR;
            PG8_LDA(At, 0, 1); PG8_STAGE(PG8_SA(0, 0), a2, voffA);
            PG8_BAR; PG8_WAIT_L(0); PG8_MMA(1, 0, At, B0); PG8_BAR; PG8_SCHED;
            PG8_STAGE(PG8_SB(0, 1), b2 + hstep, voffB);
            PG8_WAIT_V(6); PG8_BAR; PG8_MMA(1, 1, At, B1); PG8_BAR;
            PG8_LDB(B0, 1, 0); PG8_SCHED; PG8_LDA(At, 1, 0); PG8_STAGE(PG8_SA(0, 1), a2 + hstep, voffA);
            PG8_WAIT_L(8); PG8_BAR; PG8_WAIT_L(0); PG8_MMA(0, 0, At, B0); PG8_BAR; PG8_SCHED;
            PG8_LDB(B1, 1, 1); PG8_STAGE(PG8_SB(1, 0), b3, voffB);
            PG8_BAR; PG8_WAIT_L(0); PG8_MMA(0, 1, At, B1); PG8_BAR;
            PG8_LDA(At, 1, 1); PG8_STAGE(PG8_SA(1, 0), a3, voffA);
            PG8_BAR; PG8_WAIT_L(0); PG8_MMA(1, 0, At, B0); PG8_BAR; PG8_SCHED;
            PG8_STAGE(PG8_SB(1, 1), b3 + hstep, voffB);
            PG8_WAIT_V(6); PG8_BAR; PG8_MMA(1, 1, At, B1); PG8_BAR;
            }
        }
        if constexpr (ALIGN_EPI) { if (wr == 0) PG8_BAR; }
        if constexpr (!Epi::AFTER_DRAIN) { E(acc, cur, wr, wc, fr, fq); S.done(cur); }
        if (!has_next) break;
#pragma unroll
        for (int a = 0; a < 2; ++a)
#pragma unroll
            for (int b = 0; b < 2; ++b)
#pragma unroll
                for (int m = 0; m < 4; ++m)
#pragma unroll
                    for (int n = 0; n < 2; ++n) acc[a][b][m][n] = (f32x4){0.f, 0.f, 0.f, 0.f};
        cur = nxt; cA = nA; cB = nB; ++ui;
        if constexpr (ALIGN_EPI) { if (wr == 1) PG8_BAR; }
    }
    PG8_WAIT_V(0);
    if constexpr (!ALIGN_EPI) { if (wr == 0) PG8_BAR; }
    PG8_BAR;
    if constexpr (Epi::AFTER_DRAIN) { E.fused(acc, cur, wr, wc, fr, fq, lds, wid, lane); S.done(cur); }
#undef PG8_SA
#undef PG8_SB
#undef PG8_STAGE
#undef PG8_LDA
#undef PG8_LDB
#undef PG8_MMA
#undef PG8_WAIT_V
#undef PG8_WAIT_L
#undef PG8_BAR
#undef PG8_SCHED
}
}

#define GAS __attribute__((address_space(1)))
#define LAS __attribute__((address_space(3)))
typedef unsigned short bf16;
typedef unsigned v4u __attribute__((ext_vector_type(4)));
typedef unsigned v2u __attribute__((ext_vector_type(2)));
typedef float f32x2 __attribute__((ext_vector_type(2)));
typedef float f32x4 __attribute__((ext_vector_type(4)));
typedef float f32x16 __attribute__((ext_vector_type(16)));
typedef short bf16x8 __attribute__((ext_vector_type(8)));
typedef short s16x4 __attribute__((ext_vector_type(4)));
typedef GAS unsigned gu32;
#define RLX_AGENT __ATOMIC_RELAXED, __HIP_MEMORY_SCOPE_AGENT
#define LDS_WAIT() asm volatile("s_waitcnt lgkmcnt(0)" ::: "memory")
#define VM_WAIT() asm volatile("s_waitcnt vmcnt(0)" ::: "memory")
#define SBAR() __builtin_amdgcn_sched_barrier(0)
using pg8::cvt_pk_bf16;
__device__ __forceinline__ float bflo(unsigned w) { return __uint_as_float(w << 16); }
__device__ __forceinline__ float bfhi(unsigned w) { return __uint_as_float(w & 0xffff0000u); }
__device__ __forceinline__ float silu_f(float x) { return x * __builtin_amdgcn_rcpf(1.0f + __builtin_amdgcn_exp2f(-1.4426950408889634f * x)); }
__device__ __forceinline__ f32x4 silu4(f32x4 v) { f32x4 r; r.x = silu_f(v.x); r.y = silu_f(v.y); r.z = silu_f(v.z); r.w = silu_f(v.w); return r; }
__device__ __forceinline__ v2u pack4(f32x4 v) { v2u r; r.x = cvt_pk_bf16(v.x, v.y); r.y = cvt_pk_bf16(v.z, v.w); return r; }
__device__ __forceinline__ v4u pack8(f32x4 a, f32x4 b) { v4u r; r.x = cvt_pk_bf16(a.x, a.y); r.y = cvt_pk_bf16(a.z, a.w); r.z = cvt_pk_bf16(b.x, b.y); r.w = cvt_pk_bf16(b.z, b.w); return r; }
__device__ __forceinline__ f32x4 unp_lo(v4u q) { return (f32x4){bflo(q.x), bfhi(q.x), bflo(q.y), bfhi(q.y)}; }
__device__ __forceinline__ f32x4 unp_hi(v4u q) { return (f32x4){bflo(q.z), bfhi(q.z), bflo(q.w), bfhi(q.w)}; }
__device__ __forceinline__ v4u zero4() { v4u z = {0u, 0u, 0u, 0u}; asm volatile("" : "+v"(z)); return z; }
template <int M> __device__ __forceinline__ float xor_lt32(float v) { return __builtin_bit_cast(float, __builtin_amdgcn_ds_swizzle(__builtin_bit_cast(int, v), (M << 10) | 0x1f)); }
__device__ __forceinline__ float sum_halves(float v) { const unsigned u = __builtin_bit_cast(unsigned, v); const auto r = __builtin_amdgcn_permlane32_swap(u, u, false, false);
    return __builtin_bit_cast(float, (unsigned)r[0]) + __builtin_bit_cast(float, (unsigned)r[1]); }
__device__ __forceinline__ float wave_sum(float v) {
    v += xor_lt32<1>(v); v += xor_lt32<2>(v); v += xor_lt32<4>(v); v += xor_lt32<8>(v); v += xor_lt32<16>(v);
    return sum_halves(v);
}

constexpr int DM = 2048, NPR = 4096, NSM = 32768, MT = 36864, KVR = 40960, KVS = 4608;
constexpr int PROW0 = MT - 4096;
constexpr float EPS = 1e-6f;
constexpr int EVEN_IN = 11328, EVEN_NV = 11520, ODD_IN = 12288;
constexpr size_t MiB = 1u << 20;
constexpr size_t WS_CTL = 0, CTL_ZERO_BYTES = 65536;
constexpr size_t WS_MOD = 1 * MiB;
constexpr size_t WS_ROPE = 2 * MiB - 65536;
constexpr size_t WS_W = 2 * MiB;
constexpr size_t WE_IN = WS_W, WE_QB = WS_W + 45 * MiB, WE_KVB = WS_W + 48 * MiB, WE_OUT = WS_W + 52 * MiB;

constexpr size_t WS_CKV = 70 * MiB;
constexpr size_t WS_KPE = 110 * MiB;
constexpr size_t A0 = 116 * MiB;
constexpr size_t WS_MIX = A0, WS_QN = A0 + 288 * MiB, WS_HE = A0 + 324 * MiB, WS_PPB = A0 + 468 * MiB, WS_U1B = A0 + 504 * MiB, WS_QA = A0 + 592 * MiB, WS_CKVR = A0 + 628 * MiB;
constexpr size_t WS_Q = A0 + 324 * MiB, WS_KV = A0 + 432 * MiB;
constexpr size_t WS_HO = 2 * MiB, WS_STATS = 146 * MiB, WS_VR = 164 * MiB, WS_UG = 452 * MiB;
constexpr size_t WS_PEND_E = WS_HE, WS_PEND_O = WS_VR;
constexpr size_t WS_XB = 815 * MiB;
constexpr size_t WS_WO = 959 * MiB;
constexpr size_t WO_IN = WS_WO, WO_OUT = WS_WO + 48 * MiB, WO_S = WS_WO + 64 * MiB;
constexpr size_t WS_END = WS_WO + 65 * MiB;
static_assert(WS_CKVR + 36 * MiB <= WS_XB && WS_UG + 288 * MiB <= WS_XB && WS_XB + 144 * MiB <= WS_WO && WS_END == 1024 * MiB, "map");
static_assert(WS_MOD + 4 * 9 * 6144 * 4 <= WS_ROPE && WS_ROPE + 8192 <= WS_W, "map");
static_assert(WS_Q + (size_t)MT * 1536 * 2 <= WS_KV && WS_KV + (size_t)KVR * 2048 * 2 <= WS_QA, "map");
static_assert(WS_STATS + (size_t)MT * 64 * 8 <= WS_VR && WS_HO + 144 * MiB <= WS_STATS, "map");
constexpr int CW_TMO = 0, CW_BAR = 4096;
constexpr int RING_BYTES = 131072, LDSCTL_OFF = RING_BYTES, MISC_OFF = LDSCTL_OFF + 320, LDS_BYTES = 147456;

namespace att {
constexpr int KN_OFF = 0, KP_OFF = 16384, V_OFF = 24576, SLOT = 40960, SCR_OFF = 2 * SLOT, ATT_LDS = SCR_OFF + 8 * 256;
constexpr float SCALE = 0.07216878364870322f;
constexpr float THR = 8.f;
__device__ __forceinline__ int crow(int r, int hi) { return (r & 3) + 8 * (r >> 2) + 4 * hi; }
__device__ __forceinline__ unsigned cvtpk(float lo, float hi) { unsigned r; asm volatile("v_cvt_pk_bf16_f32 %0, %1, %2" : "=v"(r) : "v"(lo), "v"(hi)); return r; }
__device__ __forceinline__ void partialSM(f32x16& p0, f32x16& p1, float& m_reg, float& mn, float& alpha) {
  constexpr float C = SCALE * 1.4426950408889634f;
  float pmax = p0[0];
#pragma unroll
  for (int r = 1; r < 16; ++r) pmax = fmaxf(pmax, p0[r]);
#pragma unroll
  for (int r = 0; r < 16; ++r) pmax = fmaxf(pmax, p1[r]);
  { auto rr = __builtin_amdgcn_permlane32_swap(__float_as_uint(pmax), __float_as_uint(pmax), false, false);
    pmax = fmaxf(__uint_as_float(rr[0]), __uint_as_float(rr[1])); }
  if (__builtin_expect(__all(pmax - m_reg <= THR / SCALE), 1)) { mn = m_reg; alpha = 1.f; }
  else { mn = fmaxf(m_reg, pmax); alpha = __builtin_amdgcn_exp2f((m_reg - mn) * C); m_reg = mn; }
  float mnC = -mn * C;
#pragma unroll
  for (int r = 0; r < 16; ++r) p0[r] = fmaf(p0[r], C, mnC);
#pragma unroll
  for (int r = 0; r < 16; ++r) p1[r] = fmaf(p1[r], C, mnC);
#pragma unroll
  for (int r = 0; r < 16; ++r) p0[r] = __builtin_amdgcn_exp2f(p0[r]);
}
__device__ __forceinline__ void finishSM(f32x16& p0, f32x16& p1, float alpha, float& l_reg, bf16x8& pa0, bf16x8& pa1, bf16x8& pa2, bf16x8& pa3) {
#pragma unroll
  for (int r = 0; r < 16; ++r) p1[r] = __builtin_amdgcn_exp2f(p1[r]);
  float ps = 0;
#pragma unroll
  for (int r = 0; r < 16; ++r) ps += p0[r];
#pragma unroll
  for (int r = 0; r < 16; ++r) ps += p1[r];
  { auto rr = __builtin_amdgcn_permlane32_swap(__float_as_uint(ps), __float_as_uint(ps), false, false);
    ps = __uint_as_float(rr[0]) + __uint_as_float(rr[1]); }
  l_reg = l_reg * alpha + ps;
#define PK4(P, BASE, OUT) do { unsigned a0 = cvtpk(P[BASE + 0], P[BASE + 1]), a1 = cvtpk(P[BASE + 2], P[BASE + 3]);   \
    unsigned b0 = cvtpk(P[BASE + 4], P[BASE + 5]), b1 = cvtpk(P[BASE + 6], P[BASE + 7]);                              \
    auto r0 = __builtin_amdgcn_permlane32_swap(a0, b0, false, false); auto r1 = __builtin_amdgcn_permlane32_swap(a1, b1, false, false); \
    v4u w = {r0[0], r1[0], r0[1], r1[1]}; OUT = __builtin_bit_cast(bf16x8, w); } while (0)
  PK4(p0, 0, pa0); PK4(p0, 8, pa1); PK4(p1, 0, pa2); PK4(p1, 8, pa3);
#undef PK4
}
#ifndef QK_PF
#define QK_PF 3
#endif
#define ATT_ALL_QF 1
template <int OFF> __device__ __forceinline__ bf16x8 lds_rd128(int addr) { bf16x8 r; asm volatile("ds_read_b128 %0, %1 offset:%2" : "=v"(r) : "v"(addr), "i"(OFF)); return r; }
template <int N> __device__ __forceinline__ void lgkm_wait() { asm volatile("s_waitcnt lgkmcnt(%0)" :: "i"(N) : "memory"); __builtin_amdgcn_sched_barrier(0); }
template <int S> __device__ __forceinline__ void qkt(f32x16& p0, f32x16& p1, int kbn, int kbp, const bf16x8* qr) {
  p0 = f32x16{}; p1 = f32x16{};
  bf16x8 f0[12], f1[12];
#define LDK(d) do { if ((d) < 8) { const int a_ = kbn ^ ((d) << 5); f0[d] = lds_rd128<S * SLOT + KN_OFF>(a_); f1[d] = lds_rd128<S * SLOT + KN_OFF + 8192>(a_); } \
                    else { const int a_ = kbp ^ (((d) - 8) << 5); f0[d] = lds_rd128<S * SLOT + KP_OFF>(a_); f1[d] = lds_rd128<S * SLOT + KP_OFF + 4096>(a_); } } while (0)
#define QSTEP(d0) do { if ((d0) + QK_PF < 12) LDK((d0) + QK_PF); lgkm_wait<2 * ((d0) + QK_PF < 12 ? QK_PF : 11 - (d0))>(); \
    p0 = __builtin_amdgcn_mfma_f32_32x32x16_bf16(f0[d0], qr[d0], p0, 0, 0, 0); p1 = __builtin_amdgcn_mfma_f32_32x32x16_bf16(f1[d0], qr[d0], p1, 0, 0, 0); } while (0)
#pragma unroll
  for (int d = 0; d < QK_PF; ++d) LDK(d);
  QSTEP(0); QSTEP(1); QSTEP(2); QSTEP(3); QSTEP(4); QSTEP(5); QSTEP(6); QSTEP(7); QSTEP(8); QSTEP(9); QSTEP(10); QSTEP(11);
#undef QSTEP
#undef LDK
}
struct StepDma { const unsigned char* kn; const unsigned char* kp; const unsigned char* vp; LAS unsigned char* lk; LAS unsigned char* lv; unsigned okn, okp, ov; bool doK; };
#define ATT_GLDS_(gp, lp) __builtin_amdgcn_global_load_lds((const unsigned*)(gp), (LAS unsigned*)(lp), 16, 0, 0)
#define ATT_GLDS_AT(base, off, lp) do { unsigned o_ = (off); asm volatile("" : "+v"(o_)); __builtin_amdgcn_global_load_lds((const unsigned*)((base) + o_), (LAS unsigned*)(lp), 16, 0, 0); } while (0)
template <int S> __device__ __forceinline__ void qkt_fin(f32x16& n0, f32x16& n1, int kbn, int kbp, const bf16x8* qr,
                                                       f32x16& p0, f32x16& p1, float alpha, float& l_reg, bf16x8& pa0, bf16x8& pa1, bf16x8& pa2, bf16x8& pa3, const StepDma& dm) {
  n0 = f32x16{}; n1 = f32x16{};
  bf16x8 f0[12], f1[12]; float s0, s1, s2, s3;
#define LDK(d) do { if ((d) < 8) { const int a_ = kbn ^ ((d) << 5); f0[d] = lds_rd128<S * SLOT + KN_OFF>(a_); f1[d] = lds_rd128<S * SLOT + KN_OFF + 8192>(a_); } \
                    else { const int a_ = kbp ^ (((d) - 8) << 5); f0[d] = lds_rd128<S * SLOT + KP_OFF>(a_); f1[d] = lds_rd128<S * SLOT + KP_OFF + 4096>(a_); } } while (0)
#define QSTEP(d0) do { if ((d0) + QK_PF < 12) LDK((d0) + QK_PF); lgkm_wait<2 * ((d0) + QK_PF < 12 ? QK_PF : 11 - (d0))>(); \
    n0 = __builtin_amdgcn_mfma_f32_32x32x16_bf16(f0[d0], qr[d0], n0, 0, 0, 0); n1 = __builtin_amdgcn_mfma_f32_32x32x16_bf16(f1[d0], qr[d0], n1, 0, 0, 0); } while (0)
#define EXP4(b) do { p1[b] = __builtin_amdgcn_exp2f(p1[b]); p1[b + 1] = __builtin_amdgcn_exp2f(p1[b + 1]); p1[b + 2] = __builtin_amdgcn_exp2f(p1[b + 2]); p1[b + 3] = __builtin_amdgcn_exp2f(p1[b + 3]); } while (0)
#define SUM8(P, b) (((P[b] + P[b + 1]) + (P[b + 2] + P[b + 3])) + ((P[b + 4] + P[b + 5]) + (P[b + 6] + P[b + 7])))
#define PK4(P, BASE, OUT) do { unsigned a0 = cvtpk(P[BASE + 0], P[BASE + 1]), a1 = cvtpk(P[BASE + 2], P[BASE + 3]);   \
    unsigned b0 = cvtpk(P[BASE + 4], P[BASE + 5]), b1 = cvtpk(P[BASE + 6], P[BASE + 7]);                              \
    auto r0 = __builtin_amdgcn_permlane32_swap(a0, b0, false, false); auto r1 = __builtin_amdgcn_permlane32_swap(a1, b1, false, false); \
    v4u w = {r0[0], r1[0], r0[1], r1[1]}; OUT = __builtin_bit_cast(bf16x8, w); } while (0)
#pragma unroll
  for (int d = 0; d < QK_PF; ++d) LDK(d);
  QSTEP(0); s0 = SUM8(p0, 0); if (dm.doK) ATT_GLDS_AT(dm.kn, dm.okn, dm.lk + KN_OFF);
  QSTEP(1); s1 = SUM8(p0, 8); if (dm.doK) ATT_GLDS_AT(dm.kn + 32 * 4096, dm.okn, dm.lk + KN_OFF + 8192);
  QSTEP(2); PK4(p0, 0, pa0);  if (dm.doK) ATT_GLDS_AT(dm.kp, dm.okp, dm.lk + KP_OFF);
  QSTEP(3); PK4(p0, 8, pa1);  ATT_GLDS_AT(dm.vp, dm.ov, dm.lv);
  QSTEP(4); EXP4(0);          ATT_GLDS_AT(dm.vp + 32 * 4096, dm.ov, dm.lv + 8192);
  QSTEP(5); EXP4(4);
  QSTEP(6); EXP4(8);
  QSTEP(7); EXP4(12);
  QSTEP(8); s2 = SUM8(p1, 0);
  QSTEP(9); s3 = SUM8(p1, 8);
  { float ps = (s0 + s1) + (s2 + s3); auto rr = __builtin_amdgcn_permlane32_swap(__float_as_uint(ps), __float_as_uint(ps), false, false);
    ps = __uint_as_float(rr[0]) + __uint_as_float(rr[1]); l_reg = l_reg * alpha + ps; }
  QSTEP(10); PK4(p1, 0, pa2);
  QSTEP(11); PK4(p1, 8, pa3);
#undef PK4
#undef SUM8
#undef EXP4
#undef QSTEP
#undef LDK
}
__device__ __forceinline__ int v_st(int k, int c) { const int kk = (k & ~0xC) | ((k & 4) << 1) | ((k & 8) >> 1); return ((kk >> 3) * 4 + (c >> 5)) * 512 + ((kk & 7) * 32 + (c & 31)) * 2; }
__device__ __forceinline__ int v_rd_base(int lane) { return ((lane & 3) << 3) | (((lane >> 2) & 3) << 6) | (((lane >> 4) & 1) << 5) | (((lane >> 5) & 1) << 8); }
constexpr int v_rd_off(int d0, int ks, int half) { return d0 * 512 + ks * 4096 + half * 2048; }
template <int OFF> __device__ __forceinline__ s16x4 tr_read(int vb) {
  s16x4 r; asm volatile("ds_read_b64_tr_b16 %0, %1 offset:%2" : "=&v"(r) : "v"(vb), "i"(OFF) : "memory"); return r;
}
struct VGrp { s16x4 l0, h0, l1, h1, l2, h2, l3, h3; };
template <int D0> __device__ __forceinline__ void v_load(VGrp& g, int vb) {
  g.l0 = tr_read<v_rd_off(D0, 0, 0)>(vb); g.h0 = tr_read<v_rd_off(D0, 0, 1)>(vb); g.l1 = tr_read<v_rd_off(D0, 1, 0)>(vb); g.h1 = tr_read<v_rd_off(D0, 1, 1)>(vb);
  g.l2 = tr_read<v_rd_off(D0, 2, 0)>(vb); g.h2 = tr_read<v_rd_off(D0, 2, 1)>(vb); g.l3 = tr_read<v_rd_off(D0, 3, 0)>(vb); g.h3 = tr_read<v_rd_off(D0, 3, 1)>(vb);
}
template <int N> __device__ __forceinline__ void v_wait() { asm volatile("s_waitcnt lgkmcnt(%0)" :: "i"(N) : "memory"); SBAR(); }
__device__ __forceinline__ void v_mma(f32x16& od, const VGrp& g, bf16x8 pa0, bf16x8 pa1, bf16x8 pa2, bf16x8 pa3) {
#define PK(L, H) (bf16x8){L[0], L[1], L[2], L[3], H[0], H[1], H[2], H[3]}
  od = __builtin_amdgcn_mfma_f32_32x32x16_bf16(pa0, PK(g.l0, g.h0), od, 0, 0, 0);
  od = __builtin_amdgcn_mfma_f32_32x32x16_bf16(pa1, PK(g.l1, g.h1), od, 0, 0, 0);
  od = __builtin_amdgcn_mfma_f32_32x32x16_bf16(pa2, PK(g.l2, g.h2), od, 0, 0, 0);
  od = __builtin_amdgcn_mfma_f32_32x32x16_bf16(pa3, PK(g.l3, g.h3), od, 0, 0, 0);
#undef PK
}
__device__ __forceinline__ void pv_d0(f32x16* o, int vb, bf16x8 pa0, bf16x8 pa1, bf16x8 pa2, bf16x8 pa3) {
  VGrp a, b;
  v_load<0>(a, vb); v_load<1>(b, vb);
  v_wait<8>(); v_mma(o[0], a, pa0, pa1, pa2, pa3); SBAR();
  v_load<2>(a, vb);
  v_wait<8>(); v_mma(o[1], b, pa0, pa1, pa2, pa3); SBAR();
  v_load<3>(b, vb);
  v_wait<8>(); v_mma(o[2], a, pa0, pa1, pa2, pa3); SBAR();
  v_wait<0>(); v_mma(o[3], b, pa0, pa1, pa2, pa3);
}
__device__ __forceinline__ void pv_part(f32x16* o, int vb, bf16x8 pa0, bf16x8 pa1, bf16x8 pa2, bf16x8 pa3, f32x16& p0, f32x16& p1, float& m_reg, float& alpha) {
  constexpr float C = SCALE * 1.4426950408889634f;
  VGrp a, b;
  v_load<0>(a, vb); v_load<1>(b, vb);
  v_wait<8>(); v_mma(o[0], a, pa0, pa1, pa2, pa3);
  float pmax = fmaxf(p0[0], p0[1]);
#pragma unroll
  for (int r = 2; r < 16; ++r) pmax = fmaxf(pmax, p0[r]);
#pragma unroll
  for (int r = 0; r < 16; ++r) pmax = fmaxf(pmax, p1[r]);
  asm volatile("" : "+v"(pmax)); SBAR();
  v_load<2>(a, vb);
  v_wait<8>(); v_mma(o[1], b, pa0, pa1, pa2, pa3);
  { auto rr = __builtin_amdgcn_permlane32_swap(__float_as_uint(pmax), __float_as_uint(pmax), false, false); pmax = fmaxf(__uint_as_float(rr[0]), __uint_as_float(rr[1])); }
  const bool keep = __all(pmax - m_reg <= THR / SCALE);
  const float mn = keep ? m_reg : fmaxf(m_reg, pmax);
  alpha = __builtin_amdgcn_exp2f((m_reg - mn) * C); m_reg = mn;
  const float mnC = -mn * C;
#pragma unroll
  for (int r = 0; r < 16; ++r) p0[r] = fmaf(p0[r], C, mnC);
  asm volatile("" : "+v"(p0)); SBAR();
  v_load<3>(b, vb);
  v_wait<8>(); v_mma(o[2], a, pa0, pa1, pa2, pa3);
#pragma unroll
  for (int r = 0; r < 16; ++r) p1[r] = fmaf(p1[r], C, mnC);
#pragma unroll
  for (int r = 0; r < 6; ++r) p0[r] = __builtin_amdgcn_exp2f(p0[r]);
  asm volatile("" : "+v"(p0), "+v"(p1)); SBAR();
  v_wait<0>(); v_mma(o[3], b, pa0, pa1, pa2, pa3);
#pragma unroll
  for (int r = 6; r < 16; ++r) p0[r] = __builtin_amdgcn_exp2f(p0[r]);
  asm volatile("" : "+v"(p0));
}
#define ATT_GLDS(gp, lp) __builtin_amdgcn_global_load_lds((const unsigned*)(gp), (LAS unsigned*)(lp), 16, 0, 0)
#define ATT_BAR() do { asm volatile("" ::: "memory"); __builtin_amdgcn_s_barrier(); asm volatile("" ::: "memory"); } while (0)
__device__ __forceinline__ void unit(LAS unsigned char* lds, const bf16* __restrict__ Qb, int ldq, const unsigned char* __restrict__ Kn, const unsigned char* __restrict__ Vp, const unsigned char* __restrict__ Kp,
                                     int NT, bf16* Ob, int ldo, const bf16* Gb, int ldg) {
  int tid_ = threadIdx.x; asm volatile("" : "+v"(tid_));
  const int tid = tid_, wid = __builtin_amdgcn_readfirstlane(tid >> 6), lane = tid & 63, r32 = lane & 31, hi = lane >> 5;
  LAS float* scr = (LAS float*)(lds + SCR_OFF) + wid * 64; LAS float* li_l = scr; LAS float* al_l = scr + 32;
  float m_reg = -1e30f, l_reg = 0.f; f32x16 o[4] = {}; bf16x8 qr[12];
  { const bf16* Qw = Qb + (size_t)(wid * 32 + r32) * ldq + hi * 8;
#pragma unroll
    for (int d0 = 0; d0 < 12; ++d0) qr[d0] = *(const bf16x8*)(Qw + d0 * 16); }
  const unsigned offKn = (unsigned)((4 * wid + (lane >> 4)) * 4096 + (((lane & 15) ^ ((4 * wid + (lane >> 4)) & 15)) << 4));
  const unsigned offKp = (unsigned)((8 * wid + (lane >> 3)) * 128 + (((lane & 7) ^ (((8 * wid + (lane >> 3)) >> 1) & 7)) << 4));
  unsigned offV; { const int kk = 8 * (wid >> 1) + ((lane & 31) >> 2); const int k = (kk & ~0xC) | ((kk & 4) << 1) | ((kk & 8) >> 1); const int c = (2 * (wid & 1) + (lane >> 5)) * 32 + 8 * (lane & 3); offV = (unsigned)(k * 4096 + c * 2); }
  const int vb0 = (int)(unsigned)(uintptr_t)(lds + V_OFF) + v_rd_base(lane);
  const int kbn = (int)(unsigned)(uintptr_t)lds + r32 * 256 + ((hi ^ (r32 & 1)) << 4) + (((r32 & 15) >> 1) << 5);
  const int kbp = (int)(unsigned)(uintptr_t)lds + r32 * 128 + ((hi ^ ((r32 >> 1) & 1)) << 4) + ((((r32 >> 1) & 7) >> 1) << 5);
#define ISSUE_K(j, s) do { const unsigned char* g_ = Kn + (size_t)(j) * (64 * 4096) + offKn; LAS unsigned char* l_ = lds + (s) * SLOT + KN_OFF + wid * 1024; \
    ATT_GLDS(g_, l_); ATT_GLDS(g_ + 32 * 4096, l_ + 8192); ATT_GLDS(Kp + (size_t)(j) * (64 * 128) + offKp, lds + (s) * SLOT + KP_OFF + wid * 1024); } while (0)
#define ISSUE_V(j, s) do { const unsigned char* g_ = Vp + (size_t)(j) * (64 * 4096) + offV; LAS unsigned char* l_ = lds + (s) * SLOT + V_OFF + wid * 1024; \
    ATT_GLDS(g_, l_); ATT_GLDS(g_ + 32 * 4096, l_ + 8192); } while (0)
#define RESC(a) do { if (__any((a) < 1.f)) { if (hi == 0) al_l[r32] = (a); asm volatile("s_waitcnt lgkmcnt(0)" ::: "memory"); \
    _Pragma("unroll") for (int d = 0; d < 4; ++d) _Pragma("unroll") for (int r = 0; r < 16; ++r) o[d][r] *= al_l[crow(r, hi)]; } } while (0)
#define STEP_END() do { asm volatile("s_waitcnt vmcnt(0)" ::: "memory"); ATT_BAR(); } while (0)
  f32x16 pA0, pA1, pB0, pB1; float mnA, mnB, alA, alB; bf16x8 pa0, pa1, pa2, pa3;
#define STEP_QF(N0, N1, mnN, alN, P0, P1, alP, kslot, vbase, DM) do { SBAR(); qkt_fin<kslot>(N0, N1, kbn, kbp, qr, P0, P1, alP, l_reg, pa0, pa1, pa2, pa3, DM); SBAR(); \
    pv_part(o, vbase, pa0, pa1, pa2, pa3, N0, N1, m_reg, alN); SBAR(); RESC(alN); } while (0)
#define MK_DMA(jk, sk, jv, sv, dok) StepDma{Kn + (size_t)(jk) * (64 * 4096), Kp + (size_t)(jk) * (64 * 128), Vp + (size_t)(jv) * (64 * 4096), \
    lds + (sk) * SLOT + wid * 1024, lds + (sv) * SLOT + V_OFF + wid * 1024, offKn, offKp, offV, (dok)}
#define MAINLOOP_QF() do { \
  ISSUE_K(0, 0); STEP_END(); \
  ISSUE_K(1, 1); ISSUE_V(0, 0); \
  qkt<0>(pA0, pA1, kbn, kbp, qr); partialSM(pA0, pA1, m_reg, mnA, alA); \
  STEP_END(); \
  for (int j = 1; j + 1 < NT; j += 2) { \
    { const StepDma dm_ = MK_DMA(j + 1, 0, j, 1, true); STEP_QF(pB0, pB1, mnB, alB, pA0, pA1, alA, 1, vb0, dm_); } STEP_END(); \
    { const StepDma dm_ = MK_DMA(j + 2, 1, j + 1, 0, j + 2 < NT); STEP_QF(pA0, pA1, mnA, alA, pB0, pB1, alB, 0, vb0 + SLOT, dm_); } STEP_END(); \
  } \
  { const StepDma dm_ = MK_DMA(NT - 1, 0, NT - 1, 1, false); STEP_QF(pB0, pB1, mnB, alB, pA0, pA1, alA, 1, vb0, dm_); } STEP_END(); \
  finishSM(pB0, pB1, alB, l_reg, pa0, pa1, pa2, pa3); SBAR(); \
  pv_d0(o, vb0 + SLOT, pa0, pa1, pa2, pa3); } while (0)
#define STEP_FQ(N0, N1, mnN, alN, P0, P1, alP, kslot, vbase) do { finishSM(P0, P1, alP, l_reg, pa0, pa1, pa2, pa3); SBAR(); pv_d0(o, vbase, pa0, pa1, pa2, pa3); SBAR(); \
    qkt<kslot>(N0, N1, kbn, kbp, qr); partialSM(N0, N1, m_reg, mnN, alN); RESC(alN); } while (0)
#define MAINLOOP(STEP) do { \
  ISSUE_K(0, 0); STEP_END(); \
  ISSUE_K(1, 1); ISSUE_V(0, 0); \
  qkt<0>(pA0, pA1, kbn, kbp, qr); partialSM(pA0, pA1, m_reg, mnA, alA); \
  STEP_END(); \
  for (int j = 1; j + 1 < NT; j += 2) { \
    ISSUE_K(j + 1, 0); ISSUE_V(j, 1); \
    STEP(pB0, pB1, mnB, alB, pA0, pA1, alA, 1, vb0); STEP_END(); \
    if (j + 2 < NT) ISSUE_K(j + 2, 1); \
    ISSUE_V(j + 1, 0); \
    STEP(pA0, pA1, mnA, alA, pB0, pB1, alB, 0, vb0 + SLOT); STEP_END(); \
  } \
  ISSUE_V(NT - 1, 1); \
  STEP(pB0, pB1, mnB, alB, pA0, pA1, alA, 1, vb0); STEP_END(); \
  finishSM(pB0, pB1, alB, l_reg, pa0, pa1, pa2, pa3); SBAR(); \
  pv_d0(o, vb0 + SLOT, pa0, pa1, pa2, pa3); } while (0)
#if defined(ATT_ALL_QF)
  MAINLOOP_QF();
#elif defined(ATT_ALL_FQ)
  MAINLOOP(STEP_FQ);
#else
  MAINLOOP(STEP_FQ);
#endif
#undef MAINLOOP
#undef MAINLOOP_QF
#undef MK_DMA
#undef STEP_QF
#undef STEP_FQ
  if (hi == 0) li_l[r32] = l_reg; asm volatile("s_waitcnt lgkmcnt(0)" ::: "memory");
  float rli[16];
#pragma unroll
  for (int r = 0; r < 16; ++r) rli[r] = __builtin_amdgcn_rcpf(li_l[crow(r, hi)]);
  ATT_BAR();
  { LAS unsigned char* stg = lds + wid * 8192;
#pragma unroll
    for (int r = 0; r < 16; ++r) {
#pragma unroll
      for (int d0 = 0; d0 < 4; ++d0) *(LAS bf16*)(stg + crow(r, hi) * 256 + (d0 * 32 + r32) * 2) = (bf16)(cvtpk(o[d0][r] * rli[r], 0.f) & 0xffffu); }
    asm volatile("s_waitcnt lgkmcnt(0)" ::: "memory");
#pragma unroll
    for (int j = 0; j < 8; ++j) { const int id = lane + 64 * j, row = id >> 4, cg = id & 15, orow = wid * 32 + row;
      const v4u a = *(const LAS v4u*)(stg + row * 256 + cg * 16), g = *(const v4u*)(Gb + (size_t)orow * ldg + cg * 8);
      v4u w; w.x = cvtpk(bflo(a.x) * bflo(g.x), bfhi(a.x) * bfhi(g.x)); w.y = cvtpk(bflo(a.y) * bflo(g.y), bfhi(a.y) * bfhi(g.y));
      w.z = cvtpk(bflo(a.z) * bflo(g.z), bfhi(a.z) * bfhi(g.z)); w.w = cvtpk(bflo(a.w) * bflo(g.w), bfhi(a.w) * bfhi(g.w));
      *(v4u*)(Ob + (size_t)orow * ldo + cg * 8) = w; } }
  ATT_BAR();
#undef ISSUE_K
#undef ISSUE_V
#undef RESC
#undef STEP_END
}
}

namespace pg8 {
__device__ __forceinline__ float dpp_shr1(float v) { return __builtin_bit_cast(float, __builtin_amdgcn_update_dpp(0, __builtin_bit_cast(int, v), 0x111, 0xf, 0xf, true)); }
__device__ __forceinline__ float dpp_shl1(float v) { return __builtin_bit_cast(float, __builtin_amdgcn_update_dpp(0, __builtin_bit_cast(int, v), 0x101, 0xf, 0xf, true)); }
__device__ __forceinline__ int kvrow_of(int row) { return row < NPR ? row : NPR + ((row - NPR) >> 12) * KVS + 512 + ((row - NPR) & 4095); }
struct EpiEvenIn {
    static constexpr bool PERM = false, AFTER_DRAIN = false;
    bf16 *MIX, *PPB, *U1B, *QA, *CKVR, *KPE; float* nkpe; const float* rope; const float* cw;
    __device__ __forceinline__ void operator()(const f32x4 (&acc)[2][2][4][2], const Unit& u, int wr, int wc, int fr, int fq) const {
        const int row0 = u.pm * BM + wr * 64 + fr, pn = u.pn;
        if (pn < 32) {
            const int ch = 64 * pn + 16 * wc + 4 * fq;
            const f32x4 w0 = *(const f32x4*)(cw + ch), w1 = *(const f32x4*)(cw + 2048 + ch), w2 = *(const f32x4*)(cw + 4096 + ch);
            const bool edge = fr == 0 || fr == 15, nearb = edge || fr == 1 || fr == 14; const int slot = fr < 2 ? fr : fr - 12;
#pragma unroll
            for (int ai = 0; ai < 2; ++ai)
#pragma unroll
                for (int m = 0; m < 4; ++m) { const int row = row0 + ai * HALF + m * 16;
                    const f32x4 cb = acc[ai][0][m][0], cc = acc[ai][0][m][1], cx = acc[ai][1][m][0], cg = acc[ai][1][m][1];
                    const f32x4 p = cc * cx, u1 = cb * silu4(cg);
                    const f32x4 pm = {dpp_shr1(p.x), dpp_shr1(p.y), dpp_shr1(p.z), dpp_shr1(p.w)};
                    const f32x4 pp = {dpp_shl1(p.x), dpp_shl1(p.y), dpp_shl1(p.z), dpp_shl1(p.w)};
                    if (!edge) *(v2u*)(MIX + (size_t)row * 4096 + ch) = pack4(u1 * (w0 * pm + w1 * p + w2 * pp));
                    if (nearb) *(v2u*)(PPB + ((size_t)(row >> 4) * 4 + slot) * 2048 + ch) = pack4(p);
                    if (edge) *(v2u*)(U1B + ((size_t)(row >> 4) * 2 + (fr == 15 ? 1 : 0)) * 2048 + ch) = pack4(u1); }
        } else if (pn < 36) {
            bf16* dst = pn < 34 ? QA : CKVR; const int col = (pn & 1) * 256 + 32 * wc + 8 * fq;
#pragma unroll
            for (int ai = 0; ai < 2; ++ai)
#pragma unroll
                for (int m = 0; m < 4; ++m) { bf16* rp = dst + (size_t)(row0 + ai * HALF + m * 16) * 512 + col;
#pragma unroll
                    for (int bj = 0; bj < 2; ++bj) *(v4u*)(rp + bj * HALF) = pack8(acc[ai][bj][m][0], acc[ai][bj][m][1]); }
        } else if (pn == 36) {
            if (wc < 2) {
#pragma unroll
                for (int ai = 0; ai < 2; ++ai)
#pragma unroll
                    for (int m = 0; m < 4; ++m) { const int row = row0 + ai * HALF + m * 16; f32x4 x0 = acc[ai][0][m][0], x1 = acc[ai][0][m][1];
                        if (row < NPR) { float* op = nkpe + (size_t)(row >> 8) * (2 * 256 * 64) + (row & 255) * 64 + 32 * wc + 4 * fq; *(f32x4*)op = x0; *(f32x4*)(op + 16) = x1; }
                        else { const int nt = (row - NPR) & 4095, pos = wc == 0 ? (nt >> 6) : (nt & 63); const float* cs = rope + (pos * 16 + 4 * fq) * 2;
                            const f32x4 t0 = *(const f32x4*)cs, t1 = *(const f32x4*)(cs + 4); const f32x4 c = {t0.x, t0.z, t1.x, t1.z}, s = {t0.y, t0.w, t1.y, t1.w};
                            const f32x4 y0 = x0 * c - x1 * s, y1 = x1 * c + x0 * s; x0 = y0; x1 = y1; }
                        bf16* kp = KPE + (size_t)kvrow_of(row) * 64 + 32 * wc + 4 * fq; *(v2u*)kp = pack4(x0); *(v2u*)(kp + 16) = pack4(x1); }
            }
        } else {
            const int col = 2048 + (pn - 37) * 256 + 32 * wc + 8 * fq;
#pragma unroll
            for (int ai = 0; ai < 2; ++ai)
#pragma unroll
                for (int m = 0; m < 4; ++m) { bf16* rp = MIX + (size_t)(row0 + ai * HALF + m * 16) * 4096 + col;
#pragma unroll
                    for (int bj = 0; bj < 2; ++bj) *(v4u*)(rp + bj * HALF) = pack8(silu4(acc[ai][bj][m][0]), silu4(acc[ai][bj][m][1])); }
        }
    }
};
struct EpiStore {
    static constexpr bool PERM = false, AFTER_DRAIN = false;
    bf16* O; int ldc;
    __device__ __forceinline__ void operator()(const f32x4 (&acc)[2][2][4][2], const Unit& u, int wr, int wc, int fr, int fq) const {
        const int row0 = u.pm * BM + wr * 64 + fr, col = u.pn * BM + 32 * wc + 8 * fq;
#pragma unroll
        for (int ai = 0; ai < 2; ++ai)
#pragma unroll
            for (int m = 0; m < 4; ++m) { bf16* rp = O + (size_t)(row0 + ai * HALF + m * 16) * ldc + col;
#pragma unroll
                for (int bj = 0; bj < 2; ++bj) *(v4u*)(rp + bj * HALF) = pack8(acc[ai][bj][m][0], acc[ai][bj][m][1]); }
    }
};
struct EpiQ {
    static constexpr bool PERM = false, AFTER_DRAIN = false;
    bf16* Q; const float* rope;
    __device__ __forceinline__ void operator()(const f32x4 (&acc)[2][2][4][2], const Unit& u, int wr, int wc, int fr, int fq) const {
        const int row0 = u.pm * BM + wr * 64 + fr;
#pragma unroll
        for (int bj = 0; bj < 2; ++bj) { const int gi = 8 * u.pn + 4 * bj + wc, hl = gi / 6, sub = gi - 6 * hl;
            if (sub < 4) {
#pragma unroll
                for (int ai = 0; ai < 2; ++ai)
#pragma unroll
                    for (int m = 0; m < 4; ++m) *(v4u*)(Q + (size_t)(row0 + ai * HALF + m * 16) * 1536 + hl * 192 + 32 * sub + 8 * fq) = pack8(acc[ai][bj][m][0], acc[ai][bj][m][1]);
            } else { const int h = sub - 4;
#pragma unroll
                for (int ai = 0; ai < 2; ++ai)
#pragma unroll
                    for (int m = 0; m < 4; ++m) { const int row = row0 + ai * HALF + m * 16; f32x4 x0 = acc[ai][bj][m][0], x1 = acc[ai][bj][m][1];
                        if (row >= NPR) { const int nt = (row - NPR) & 4095, pos = h == 0 ? (nt >> 6) : (nt & 63); const float* cs = rope + (pos * 16 + 4 * fq) * 2;
                            const f32x4 t0 = *(const f32x4*)cs, t1 = *(const f32x4*)(cs + 4); const f32x4 c = {t0.x, t0.z, t1.x, t1.z}, s = {t0.y, t0.w, t1.y, t1.w};
                            const f32x4 y0 = x0 * c - x1 * s, y1 = x1 * c + x0 * s; x0 = y0; x1 = y1; }
                        bf16* qp = Q + (size_t)row * 1536 + hl * 192 + 128 + 32 * h + 4 * fq; *(v2u*)qp = pack4(x0); *(v2u*)(qp + 16) = pack4(x1); }
            }
        }
    }
};
struct EpiResid {
    static constexpr bool PERM = false, AFTER_DRAIN = false;
    const float* xp; const float* xs; bf16* xb; float* xo; const float* gate; int first, last; bf16* pend;
    __device__ __forceinline__ void operator()(const f32x4 (&acc)[2][2][4][2], const Unit& u, int wr, int wc, int fr, int fq) const {
        const int row0 = u.pm * BM + wr * 64 + fr, col0 = u.pn * BM + wc * 32 + 8 * fq;
        if (u.kh == 2) {
            const float* gq = gate + (size_t)8 * 6144 + col0;
#pragma unroll
            for (int bj = 0; bj < 2; ++bj) { const f32x4 g0 = *(const f32x4*)(gq + bj * HALF), g1 = *(const f32x4*)(gq + bj * HALF + 4);
#pragma unroll
                for (int ai = 0; ai < 2; ++ai)
#pragma unroll
                    for (int m = 0; m < 4; ++m) *(v4u*)(pend + (size_t)(row0 + ai * HALF + m * 16 - PROW0) * DM + col0 + bj * HALF) = pack8(g0 * acc[ai][bj][m][0], g1 * acc[ai][bj][m][1]); }
            return;
        }
        const int cr = u.pm < 16 ? 0 : 1 + ((u.pm - 16) >> 4);
        const float* xin = u.pm < 16 ? xp : xs - (size_t)NPR * DM;
        const float* gp = gate + (size_t)cr * 6144 + col0;
        f32x4 gv[2][2];
#pragma unroll
        for (int bj = 0; bj < 2; ++bj)
#pragma unroll
            for (int n = 0; n < 2; ++n) gv[bj][n] = *(const f32x4*)(gp + bj * HALF + n * 4);
#pragma unroll
        for (int ai = 0; ai < 2; ++ai)
#pragma unroll
            for (int m = 0; m < 4; ++m) { const size_t off = (size_t)(row0 + ai * HALF + m * 16) * DM + col0;
#pragma unroll
                for (int bj = 0; bj < 2; ++bj) { f32x4 a, b;
                    if (first) { a = *(const f32x4*)(xin + off + bj * HALF); b = *(const f32x4*)(xin + off + bj * HALF + 4); }
                    else { const v4u w = *(const v4u*)(xb + off + bj * HALF); a = (f32x4){bflo(w.x), bfhi(w.x), bflo(w.y), bfhi(w.y)}; b = (f32x4){bflo(w.z), bfhi(w.z), bflo(w.w), bfhi(w.w)}; }
                    a += gv[bj][0] * acc[ai][bj][m][0]; b += gv[bj][1] * acc[ai][bj][m][1];
                    if (last) { *(f32x4*)(xo + off + bj * HALF) = a; *(f32x4*)(xo + off + bj * HALF + 4) = b; }
                    else *(v4u*)(xb + off + bj * HALF) = pack8(a, b); }
                asm volatile("" ::: "memory"); }
    }
};
struct EpiOddIn {
    static constexpr bool PERM = false, AFTER_DRAIN = false;
    bf16 *UG, *VR; float* stats;
    __device__ __forceinline__ void operator()(const f32x4 (&acc)[2][2][4][2], const Unit& u, int wr, int wc, int fr, int fq) const {
        const int row0 = u.pm * BM + wr * 64 + fr, pn = u.pn;
        if (pn < 32) {
            const int col = 128 * pn + 32 * wc + 8 * fq;
#pragma unroll
            for (int ai = 0; ai < 2; ++ai)
#pragma unroll
                for (int m = 0; m < 4; ++m) *(v4u*)(UG + (size_t)(row0 + ai * HALF + m * 16) * 4096 + col) = pack8(acc[ai][0][m][0] * silu4(acc[ai][1][m][0]), acc[ai][0][m][1] * silu4(acc[ai][1][m][1]));
        } else {
            const int col = (pn - 32) * 256 + 32 * wc + 8 * fq;
#pragma unroll
            for (int ai = 0; ai < 2; ++ai)
#pragma unroll
                for (int m = 0; m < 4; ++m) { const int row = row0 + ai * HALF + m * 16; bf16* rp = VR + (size_t)row * 4096 + col; float s = 0.f, q = 0.f;
#pragma unroll
                    for (int bj = 0; bj < 2; ++bj) { const f32x4 a = acc[ai][bj][m][0], b = acc[ai][bj][m][1]; *(v4u*)(rp + bj * HALF) = pack8(a, b);
                        s += (a.x + a.y) + (a.z + a.w) + (b.x + b.y) + (b.z + b.w); q += (a.x * a.x + a.y * a.y) + (a.z * a.z + a.w * a.w) + (b.x * b.x + b.y * b.y) + (b.z * b.z + b.w * b.w); }
                    s += xor_lt32<16>(s); s = sum_halves(s); q += xor_lt32<16>(q); q = sum_halves(q);
                    if (fq == 0) *(f32x2*)(stats + ((size_t)row * 64 + (pn - 32) * 4 + wc) * 2) = (f32x2){s, q}; }
        }
    }
};
}

#define XB_TMO      128
#define XB_XCNT(j)  (256  + 64 * (j))
#define XB_XSUB(j)  (1280 + 64 * (j))
#define XB_XGEN(j)  (2304 + 64 * (j))
#define XB_TOP      3328
#define XB_TOPGEN   3392
#define XCD_BAR_WORDS 3456
#define XB_SPIN_CAP (1u << 18)

__device__ __forceinline__ unsigned xb_ld(unsigned* p)              { return __hip_atomic_load(p, __ATOMIC_RELAXED, __HIP_MEMORY_SCOPE_AGENT); }
__device__ __forceinline__ unsigned xb_add(unsigned* p, unsigned v) { return __hip_atomic_fetch_add(p, v, __ATOMIC_RELAXED, __HIP_MEMORY_SCOPE_AGENT); }
__device__ __forceinline__ unsigned xb_xcc_id() { return (unsigned)__builtin_amdgcn_s_getreg((3 << 11) | 20) & 0xFu; }
#define XB_SPIN(cond, bar) do { unsigned _sp = 0; while (cond) { __builtin_amdgcn_s_sleep(1); \
    if ((++_sp & 255u) == 0u) { if (xb_ld(&(bar)[XB_TMO])) break; if (_sp > XB_SPIN_CAP) { atomicAdd(&(bar)[XB_TMO], 1u); break; } } } } while (0)

struct XcdBarrier {
    unsigned* bar; unsigned x;
    volatile LAS unsigned* st;
};

__device__ __forceinline__ XcdBarrier xcd_barrier_post(unsigned* bar, volatile LAS unsigned* st) {
    XcdBarrier b; b.bar = bar; b.x = xb_xcc_id(); b.st = st;
    if (threadIdx.x == 0) (void)xb_add(&bar[XB_XCNT(b.x)], 1u);
    return b;
}
__device__ __forceinline__ void xcd_barrier_complete(unsigned* bar, unsigned x, unsigned& nloc, unsigned& nx) {
    const unsigned G = gridDim.x * gridDim.y * gridDim.z;
    unsigned sum, cnt, mine, sp = 0u;
    for (;;) {
        sum = 0u; cnt = 0u; mine = 0u;
#pragma unroll
        for (unsigned j = 0; j < 16; ++j) { const unsigned c = xb_ld(&bar[XB_XCNT(j)]); sum += c; cnt += (c > 0u) ? 1u : 0u; mine = (j == x) ? c : mine; }
        if (sum == G) break;
        __builtin_amdgcn_s_sleep(1);
        if ((++sp & 255u) == 0u) { if (xb_ld(&bar[XB_TMO])) break; if (sp > XB_SPIN_CAP) { atomicAdd(&bar[XB_TMO], 1u); break; } }
    }
    nloc = mine > 0u ? mine : 1u; nx = cnt > 0u ? cnt : 1u;
}

__device__ __forceinline__ void xcd_barrier(const XcdBarrier& b) {
    asm volatile("s_waitcnt vmcnt(0)" ::: "memory");
    __syncthreads();
    if (threadIdx.x == 0) {
        unsigned* bar = b.bar;
        __builtin_amdgcn_s_waitcnt(0);
        unsigned nloc = b.st[0], nx = b.st[1];
        if (nloc == 0u) { xcd_barrier_complete(bar, b.x, nloc, nx); b.st[0] = nloc; b.st[1] = nx; }
        const unsigned old = xb_add(&bar[XB_XSUB(b.x)], 1u);
        const unsigned gen = old / nloc;
        if (old + 1u == (gen + 1u) * nloc) {
            __builtin_amdgcn_fence(__ATOMIC_RELEASE, "agent");
            asm volatile("s_waitcnt vmcnt(0)" ::: "memory");
            const unsigned og = xb_add(&bar[XB_TOP], 1u);
            const unsigned tg = og / nx;
            if (og + 1u == (tg + 1u) * nx) xb_add(&bar[XB_TOPGEN], 1u);
            else XB_SPIN(xb_ld(&bar[XB_TOPGEN]) == tg, bar);
            __builtin_amdgcn_fence(__ATOMIC_ACQUIRE, "agent");
            xb_add(&bar[XB_XGEN(b.x)], 1u);
            asm volatile("s_waitcnt vmcnt(0)" ::: "memory");
        } else {
            XB_SPIN(xb_ld(&bar[XB_XGEN(b.x)]) == gen, bar);
            __builtin_amdgcn_fence(__ATOMIC_ACQUIRE, "agent");
            asm volatile("s_waitcnt vmcnt(0)" ::: "memory");
        }
    }
    __syncthreads();
}

__device__ __forceinline__ int inv32(int j) { return 16 * ((j >> 2) & 1) + 4 * (j >> 3) + (j & 3); }
struct DestEvenIn { __device__ __forceinline__ int operator()(int n) const {
    if (n < 8192) { const int seg = n >> 11, ch = n & 2047, t = ch >> 6, ci = ch & 63; return 256 * t + 128 * (seg >> 1) + 32 * (ci >> 4) + 16 * (seg & 1) + (ci & 15); }
    if (n < 9216) return (n & ~31) + inv32(n & 31);
    if (n < 9280) return n;
    const int m = n - 9280; return 9472 + (m & ~31) + inv32(m & 31); } };
struct DestQb { __device__ __forceinline__ int operator()(int n) const { const int h = n / 192, j = n - 192 * h; return j < 128 ? 192 * h + (j & ~31) + inv32(j & 31) : n; } };
struct DestP32 { __device__ __forceinline__ int operator()(int n) const { return (n & ~31) + inv32(n & 31); } };
struct DestId { __device__ __forceinline__ int operator()(int n) const { return n; } };
struct DestOddIn { __device__ __forceinline__ int operator()(int n) const {
    if (n < 4096) return 256 * (n >> 7) + ((n & 127) & ~31) + inv32(n & 31);
    if (n < 8192) { const int ch = n - 4096; return 8192 + (ch & ~31) + inv32(ch & 31); }
    const int ch = n - 8192; return 256 * (ch >> 7) + 128 + ((ch & 127) & ~31) + inv32(ch & 31); } };
template <class DestFn> __device__ __forceinline__ void cvt_item(const float* __restrict__ W, int K, int N, bf16* __restrict__ WT, const DestFn& dest, const float* __restrict__ kscale, LAS float* scr, int item, int lane) {
    const int nblk = N / 32, kb = item / nblk, nb = item - kb * nblk, k0 = 64 * kb, n0 = 32 * nb;
    f32x4 v[8];
#pragma unroll
    for (int i = 0; i < 8; ++i) v[i] = *(const f32x4*)(W + (size_t)(k0 + 8 * i + (lane >> 3)) * N + n0 + 4 * (lane & 7));
#pragma unroll
    for (int i = 0; i < 8; ++i) { const int kk = 8 * i + (lane >> 3); f32x4 x = v[i]; if (kscale) x = x * kscale[k0 + kk]; LAS float* p = scr + kk * 33 + 4 * (lane & 7); p[0] = x.x; p[1] = x.y; p[2] = x.z; p[3] = x.w; }
    LDS_WAIT(); asm volatile("" ::: "memory");
    const int c = lane & 7;
#pragma unroll
    for (int j = 0; j < 4; ++j) { const int n = (lane >> 3) + 8 * j; const LAS float* s = scr + (8 * c) * 33 + n;
        v4u o; o.x = cvt_pk_bf16(s[0 * 33], s[1 * 33]); o.y = cvt_pk_bf16(s[2 * 33], s[3 * 33]); o.z = cvt_pk_bf16(s[4 * 33], s[5 * 33]); o.w = cvt_pk_bf16(s[6 * 33], s[7 * 33]);
        *(v4u*)(WT + (size_t)dest(n0 + n) * K + k0 + 8 * c) = o; }
    LDS_WAIT(); asm volatile("" ::: "memory");
}
__device__ __forceinline__ void modnorm_rows(const float* __restrict__ xp, const float* __restrict__ xs, const float* __restrict__ xo, int first, const float* __restrict__ g, const float* __restrict__ mod  ,
                                             bf16* __restrict__ H, int gw, int ngw, int lane) {
    for (int rb = gw; rb < MT; rb += 2 * ngw) {
        f32x4 v[2][8];
#pragma unroll
        for (int t = 0; t < 2; ++t) { const int row = rb + t * ngw < MT ? rb + t * ngw : rb;
            const float* xr = first ? (row < NPR ? xp + (size_t)row * DM : xs + (size_t)(row - NPR) * DM) : xo + (size_t)row * DM;
#pragma unroll
            for (int j = 0; j < 8; ++j) v[t][j] = *(const f32x4*)(xr + 4 * lane + 256 * j); }
#pragma unroll
        for (int t = 0; t < 2; ++t) { const int row = rb + t * ngw; if (row >= MT) break;
            const int cr = row < NPR ? 0 : 1 + ((row - NPR) >> 12);
            const float* md = mod + (size_t)cr * 6144; float ss = 0.f;
#pragma unroll
            for (int j = 0; j < 8; ++j) ss += (v[t][j].x * v[t][j].x + v[t][j].y * v[t][j].y) + (v[t][j].z * v[t][j].z + v[t][j].w * v[t][j].w);
            const float rstd = __builtin_amdgcn_rsqf(wave_sum(ss) * (1.f / DM) + EPS);
#pragma unroll
            for (int j = 0; j < 8; ++j) { const int c = 4 * lane + 256 * j; const f32x4 gg = *(const f32x4*)(g + c), sh = *(const f32x4*)(md + c), sc = *(const f32x4*)(md + 2048 + c);
                *(v2u*)(H + (size_t)row * DM + c) = pack4(v[t][j] * rstd * gg * (sc + 1.f) + sh); } }
    }
}
__device__ __forceinline__ void modnorm_rows_bf(bf16* xb, const float* __restrict__ g, const float* __restrict__ mod  , bf16* __restrict__ H, int gw, int ngw, int lane, const bf16* pend = nullptr) {
    for (int rb = gw; rb < MT; rb += 2 * ngw) {
        v4u v[2][4];
#pragma unroll
        for (int t = 0; t < 2; ++t) { const int row = rb + t * ngw < MT ? rb + t * ngw : rb;
#pragma unroll
            for (int j = 0; j < 4; ++j) v[t][j] = *(const v4u*)(xb + (size_t)row * DM + 8 * lane + 512 * j); }
#pragma unroll
        for (int t = 0; t < 2; ++t) { const int row = rb + t * ngw; if (row >= MT) break;
            const int cr = row < NPR ? 0 : 1 + ((row - NPR) >> 12);
            const float* md = mod + (size_t)cr * 6144; float ss = 0.f; f32x4 xa[4], xc[4];
#pragma unroll
            for (int j = 0; j < 4; ++j) { xa[j] = unp_lo(v[t][j]); xc[j] = unp_hi(v[t][j]); }
            if (pend && row >= PROW0) { const bf16* pr = pend + (size_t)(row - PROW0) * DM + 8 * lane;
#pragma unroll
                for (int j = 0; j < 4; ++j) { const v4u pw = *(const v4u*)(pr + 512 * j); xa[j] += unp_lo(pw); xc[j] += unp_hi(pw); *(v4u*)(xb + (size_t)row * DM + 8 * lane + 512 * j) = pack8(xa[j], xc[j]); } }
#pragma unroll
            for (int j = 0; j < 4; ++j)
                ss += (xa[j].x * xa[j].x + xa[j].y * xa[j].y) + (xa[j].z * xa[j].z + xa[j].w * xa[j].w) + (xc[j].x * xc[j].x + xc[j].y * xc[j].y) + (xc[j].z * xc[j].z + xc[j].w * xc[j].w);
            const float rstd = __builtin_amdgcn_rsqf(wave_sum(ss) * (1.f / DM) + EPS);
#pragma unroll
            for (int j = 0; j < 4; ++j) { const int c = 8 * lane + 512 * j;
                const f32x4 g0 = *(const f32x4*)(g + c), g1 = *(const f32x4*)(g + c + 4), s0 = *(const f32x4*)(md + c), s1 = *(const f32x4*)(md + c + 4), c0 = *(const f32x4*)(md + 2048 + c), c1 = *(const f32x4*)(md + 2048 + c + 4);
                *(v4u*)(H + (size_t)row * DM + c) = pack8(xa[j] * rstd * g0 * (c0 + 1.f) + s0, xc[j] * rstd * g1 * (c1 + 1.f) + s1); } }
    }
}
__device__ __forceinline__ void adaln_item(LAS unsigned char* lds, const float* __restrict__ c, const float* __restrict__ c_ctx, const float* __restrict__ w_ada, const float* __restrict__ b_ada, float* __restrict__ MOD, int item, int tid) {
    LAS float* sc = (LAS float*)lds;
#pragma unroll 6
    for (int i = tid; i < 9 * 2048; i += 512) { const int r = i >> 11, k = i & 2047; sc[i] = silu_f(r == 0 ? c_ctx[k] : c[(r - 1) * 2048 + k]); }
    __syncthreads();
    const int l = item / 24, cb = item - 24 * l, lane = tid & 63, w = tid >> 6;
    const float* W = w_ada + ((size_t)l * 2048 + w * 256) * 6144 + cb * 256 + lane * 4;
    f32x4 acc[9];
#pragma unroll
    for (int r = 0; r < 9; ++r) acc[r] = (f32x4){0.f, 0.f, 0.f, 0.f};
#pragma unroll 4
    for (int k = 0; k < 256; k += 4) {
        const f32x4 w0 = *(const f32x4*)(W + (size_t)(k + 0) * 6144), w1 = *(const f32x4*)(W + (size_t)(k + 1) * 6144), w2 = *(const f32x4*)(W + (size_t)(k + 2) * 6144), w3 = *(const f32x4*)(W + (size_t)(k + 3) * 6144);
#pragma unroll
        for (int r = 0; r < 9; ++r) { const f32x4 s = *(const LAS f32x4*)(sc + r * 2048 + w * 256 + k); acc[r] += w0 * s.x + w1 * s.y + w2 * s.z + w3 * s.w; }
    }
    __syncthreads();
    LAS float* red = (LAS float*)lds;
#pragma unroll
    for (int r = 0; r < 9; ++r) *(LAS f32x4*)(red + (w * 9 + r) * 256 + lane * 4) = acc[r];
    __syncthreads();
    for (int o = tid; o < 9 * 256; o += 512) { const int r = o >> 8, cc = o & 255; float s = b_ada[l * 6144 + cb * 256 + cc];
#pragma unroll
        for (int w2 = 0; w2 < 8; ++w2) s += red[(w2 * 9 + r) * 256 + cc];
        MOD[(size_t)(l * 9 + r) * 6144 + cb * 256 + cc] = s; }
    __syncthreads();
}
__device__ const double ROPE_CT[16] = {0.5403023058681398, 0.8460091102817079, 0.9504152802551828, 0.9842302344700946, 0.9950041652780258, 0.9984192777926645, 0.9995000416652778, 0.9998418902836144,
                                       0.9999500004166653, 0.9999841886533658, 0.9999950000041666, 0.9999984188615866, 0.9999995000000417, 0.9999998418861211, 0.9999999500000004, 0.9999999841886117};
__device__ const double ROPE_ST[16] = {0.8414709848078965, 0.5331684399140229, 0.31098359290718575, 0.17689218624615005, 0.09983341664682814, 0.056204499214692484, 0.03161750640243371, 0.01778185687966613,
                                       0.009999833334166664, 0.005623383613960186, 0.0031622723897082477, 0.0017782784728035289, 0.0009999998333333417, 0.0005623412955523593, 0.0003162277607463752, 0.00017782794006665676};
__device__ __forceinline__ void e3_norm_rows(const bf16* __restrict__ QA, const bf16* __restrict__ CKVR, const float* __restrict__ kvg, bf16* __restrict__ QN, bf16* __restrict__ CKV, float* __restrict__ nckv  ,
                                             int gw, int ngw, int lane) {
    const f32x4 g0 = *(const f32x4*)(kvg + 8 * lane), g1 = *(const f32x4*)(kvg + 8 * lane + 4);
    for (int rb = gw; rb < MT; rb += 4 * ngw) {
        v4u wq[4], wc[4];
#pragma unroll
        for (int t = 0; t < 4; ++t) { const int row = rb + t * ngw; if (row < MT) { wq[t] = *(const v4u*)(QA + (size_t)row * 512 + 8 * lane); wc[t] = *(const v4u*)(CKVR + (size_t)row * 512 + 8 * lane); } else { wq[t] = zero4(); wc[t] = wq[t]; } }
#pragma unroll
        for (int t = 0; t < 4; ++t) { const int row = rb + t * ngw; if (row >= MT) break;
            { const f32x4 a = unp_lo(wq[t]), b = unp_hi(wq[t]); const float ss = (a.x * a.x + a.y * a.y) + (a.z * a.z + a.w * a.w) + (b.x * b.x + b.y * b.y) + (b.z * b.z + b.w * b.w);
              const float rstd = __builtin_amdgcn_rsqf(wave_sum(ss) * (1.f / 512.f) + EPS);
              *(v4u*)(QN + (size_t)row * 512 + 8 * lane) = pack8(a * rstd, b * rstd); }
            { const f32x4 a = unp_lo(wc[t]), b = unp_hi(wc[t]); const float ss = (a.x * a.x + a.y * a.y) + (a.z * a.z + a.w * a.w) + (b.x * b.x + b.y * b.y) + (b.z * b.z + b.w * b.w);
              const float rstd = __builtin_amdgcn_rsqf(wave_sum(ss) * (1.f / 512.f) + EPS);
              const f32x4 y0 = a * rstd * g0, y1 = b * rstd * g1;
              *(v4u*)(CKV + (size_t)pg8::kvrow_of(row) * 512 + 8 * lane) = pack8(y0, y1);
              if (row < NPR) { float* op = nckv + (size_t)(row >> 8) * (2 * 256 * 512) + (row & 255) * 512 + 8 * lane; *(f32x4*)op = y0; *(f32x4*)(op + 4) = y1; } } }
    }
}
__device__ __forceinline__ void e3_cache_rows(const float* __restrict__ cckv  , const float* __restrict__ ckpe  ,
                                              bf16* __restrict__ CKV, bf16* __restrict__ KPE, int gw, int ngw, int lane) {
    for (int r = gw; r < 8 * 512; r += ngw) { const int b = r >> 9, j = r & 511; const size_t kvr = (size_t)NPR + (size_t)b * KVS + j;
        const float* sp = cckv + (size_t)b * (2 * 512 * 512) + (size_t)j * 512 + 8 * lane;
        *(v4u*)(CKV + kvr * 512 + 8 * lane) = pack8(*(const f32x4*)sp, *(const f32x4*)(sp + 4));
        if (lane < 8) { const float* kp = ckpe + (size_t)b * (2 * 512 * 64) + (size_t)j * 64 + 8 * lane; *(v4u*)(KPE + kvr * 64 + 8 * lane) = pack8(*(const f32x4*)kp, *(const f32x4*)(kp + 4)); } }
}
__device__ __forceinline__ void e3_conv_fix(const bf16* __restrict__ U1B, const bf16* __restrict__ PPB, const float* __restrict__ cw  , bf16* __restrict__ MIX, int gw, int ngw, int lane) {
    for (int k = gw; k < MT / 8; k += ngw) { const int g = k >> 1, top = k & 1, row = 16 * g + (top ? 15 : 0);
        const bool hp = row < NPR ? (row & 255) != 0 : ((row - NPR) & 4095) != 0, hn = row < NPR ? (row & 255) != 255 : ((row - NPR) & 4095) != 4095;
        const bf16* pu_ = U1B + (size_t)k * 2048; const bf16* p1_ = PPB + ((size_t)g * 4 + (top ? 3 : 0)) * 2048;
        const bf16* p0_ = top ? PPB + ((size_t)g * 4 + 2) * 2048 : PPB + ((size_t)(g - 1) * 4 + 3) * 2048;
        const bf16* p2_ = top ? PPB + ((size_t)(g + 1) * 4 + 0) * 2048 : PPB + ((size_t)g * 4 + 1) * 2048;
        const bool l0 = top || hp, l2 = !top || hn;
#pragma unroll
        for (int it = 0; it < 4; ++it) { const int c = 8 * lane + 512 * it;
            const v4u pu = *(const v4u*)(pu_ + c), p1 = *(const v4u*)(p1_ + c); v4u p0 = zero4(), p2 = zero4();
            if (l0) p0 = *(const v4u*)(p0_ + c); if (l2) p2 = *(const v4u*)(p2_ + c);
            const f32x4 w0a = *(const f32x4*)(cw + c), w0b = *(const f32x4*)(cw + c + 4), w1a = *(const f32x4*)(cw + 2048 + c), w1b = *(const f32x4*)(cw + 2048 + c + 4), w2a = *(const f32x4*)(cw + 4096 + c), w2b = *(const f32x4*)(cw + 4096 + c + 4);
            const f32x4 ya = unp_lo(pu) * (w0a * unp_lo(p0) + w1a * unp_lo(p1) + w2a * unp_lo(p2)), yb = unp_hi(pu) * (w0b * unp_hi(p0) + w1b * unp_hi(p1) + w2b * unp_hi(p2));
            *(v4u*)(MIX + (size_t)row * 4096 + c) = pack8(ya, yb); }
    }
}
__device__ __forceinline__ void final_rows(const bf16* __restrict__ xb, float* __restrict__ xo, const float* __restrict__ g, int gw, int ngw, int lane, const bf16* pend = nullptr) {
    for (int rb = gw; rb < MT; rb += 2 * ngw) { v4u v[2][4];
#pragma unroll
        for (int t = 0; t < 2; ++t) { const int row = rb + t * ngw < MT ? rb + t * ngw : rb;
#pragma unroll
            for (int j = 0; j < 4; ++j) v[t][j] = *(const v4u*)(xb + (size_t)row * DM + 8 * lane + 512 * j); }
#pragma unroll
        for (int t = 0; t < 2; ++t) { const int row = rb + t * ngw; if (row >= MT) break; float* xr = xo + (size_t)row * DM; float ss = 0.f; f32x4 xa[4], xc[4];
#pragma unroll
            for (int j = 0; j < 4; ++j) { xa[j] = unp_lo(v[t][j]); xc[j] = unp_hi(v[t][j]); }
            if (pend && row >= PROW0) { const bf16* pr = pend + (size_t)(row - PROW0) * DM + 8 * lane;
#pragma unroll
                for (int j = 0; j < 4; ++j) { const v4u pw = *(const v4u*)(pr + 512 * j); xa[j] += unp_lo(pw); xc[j] += unp_hi(pw); } }
#pragma unroll
            for (int j = 0; j < 4; ++j)
                ss += (xa[j].x * xa[j].x + xa[j].y * xa[j].y) + (xa[j].z * xa[j].z + xa[j].w * xa[j].w) + (xc[j].x * xc[j].x + xc[j].y * xc[j].y) + (xc[j].z * xc[j].z + xc[j].w * xc[j].w);
            const float rstd = __builtin_amdgcn_rsqf(wave_sum(ss) * (1.f / DM) + EPS);
#pragma unroll
            for (int j = 0; j < 4; ++j) { const int c = 8 * lane + 512 * j; *(f32x4*)(xr + c) = xa[j] * rstd * *(const f32x4*)(g + c); *(f32x4*)(xr + c + 4) = xc[j] * rstd * *(const f32x4*)(g + c + 4); } } }
}
__device__ __forceinline__ void sg_phase(LAS unsigned char* lds, int vcu, int G, const bf16* __restrict__ VR, const float* __restrict__ stats, const float* __restrict__ lng, const float* __restrict__ lnb,
                                         const bf16* __restrict__ WsB  , const float* __restrict__ bs  , bf16* __restrict__ UG) {
    int tid_ = threadIdx.x; asm volatile("" : "+v"(tid_));
    const int tid = tid_, wid = __builtin_amdgcn_readfirstlane(tid >> 6), lane = tid & 63, r32 = lane & 31, hi = lane >> 5;
    constexpr int NUNITS = 288 * 8;
    if (vcu >= NUNITS) return;
    const int nU = (NUNITS - vcu + G - 1) / G, nS = 2 * nU;
    LAS f32x2* ST = (LAS f32x2*)(lds + 65536);
    for (int r = tid; r < nU * 128; r += 512) { const int c = (vcu + (r >> 7) * G) >> 3; const f32x4* sp = (const f32x4*)(stats + (size_t)(c * 128 + (r & 127)) * 128); float s = 0.f, q = 0.f;
#pragma unroll 16
        for (int k = 0; k < 32; ++k) { const f32x4 v = sp[k]; s += v.x + v.z; q += v.y + v.w; }
        const float mean = s * (1.f / 4096.f), var = q * (1.f / 4096.f) - mean * mean; ST[r] = (f32x2){mean, __builtin_amdgcn_rsqf(var + EPS)}; }
    const int pb = wid & 3, dh = wid >> 2, q0 = tid >> 5, d = 8 * (tid & 31);
    v4u vr[8];
#define SG_LOAD_VR(s_) do { const int sn_ = (s_), un_ = vcu + (sn_ >> 1) * G; const bf16* vp_ = VR + (size_t)((un_ >> 3) * 128 + q0) * 4096 + (2 * (un_ & 7) + (sn_ & 1)) * 256 + d; \
        _Pragma("unroll") for (int k = 0; k < 8; ++k) vr[k] = *(const v4u*)(vp_ + (size_t)k * 16 * 4096); } while (0)
    SG_LOAD_VR(0);
    __syncthreads();
    for (int s = 0; s < nS; ++s) {
        const int u = vcu + (s >> 1) * G, c = u >> 3, g = 2 * (u & 7) + (s & 1), r0 = 128 * c;
        { const float* gp = lng + g * 256 + d; const float* bp = lnb + g * 256 + d; const f32x4 ga = *(const f32x4*)gp, gb = *(const f32x4*)(gp + 4), ba = *(const f32x4*)bp, bb = *(const f32x4*)(bp + 4);
#pragma unroll
          for (int k = 0; k < 8; ++k) { const int q = q0 + 16 * k; const f32x2 st = ST[(s >> 1) * 128 + q]; const v4u w = vr[k];
            const f32x4 ya = (unp_lo(w) - st.x) * st.y * ga + ba, yb = (unp_hi(w) - st.x) * st.y * gb + bb;
            *(LAS v4u*)(lds + ((q >> 6) * 2 + (d >> 7)) * 16384 + att::v_st(q & 63, d & 127)) = pack8(ya, yb); } }
        v4u ug[8]; bf16* up = UG + (size_t)(r0 + q0) * 4096 + g * 256 + d;
#pragma unroll
        for (int k = 0; k < 8; ++k) ug[k] = *(const v4u*)(up + (size_t)k * 16 * 4096);
        if (s + 1 < nS) SG_LOAD_VR(s + 1);
        bf16x8 afr[8];
        { const bf16* ap = WsB + ((size_t)(g * 128 + 32 * pb + r32)) * 128 + 8 * hi;
#pragma unroll
          for (int t = 0; t < 8; ++t) afr[t] = *(const bf16x8*)(ap + 16 * t); }
        float bsv[16];
#pragma unroll
        for (int r = 0; r < 16; ++r) bsv[r] = bs[g * 128 + 32 * pb + att::crow(r, hi)];
        __syncthreads();
        f32x16 od[4] = {};
#pragma unroll
        for (int qh = 0; qh < 2; ++qh) { const int vb = (int)(unsigned)(uintptr_t)(lds + (qh * 2 + dh) * 16384) + att::v_rd_base(lane);
            att::pv_d0(od, vb, afr[4 * qh + 0], afr[4 * qh + 1], afr[4 * qh + 2], afr[4 * qh + 3]); }
        __syncthreads();
#pragma unroll
        for (int r = 0; r < 16; ++r) { const int p = 32 * pb + att::crow(r, hi);
#pragma unroll
            for (int d0 = 0; d0 < 4; ++d0) *(LAS bf16*)(lds + p * 512 + (dh * 128 + d0 * 32 + r32) * 2) = (bf16)(cvt_pk_bf16(od[d0][r] + bsv[r], 0.f) & 0xffffu); }
        __syncthreads();
#pragma unroll
        for (int k = 0; k < 8; ++k) { const v4u a = *(const LAS v4u*)(lds + (q0 + 16 * k) * 512 + 2 * d), w = ug[k];
            v4u o; o.x = cvt_pk_bf16(bflo(a.x) * bflo(w.x), bfhi(a.x) * bfhi(w.x)); o.y = cvt_pk_bf16(bflo(a.y) * bflo(w.y), bfhi(a.y) * bfhi(w.y));
            o.z = cvt_pk_bf16(bflo(a.z) * bflo(w.z), bfhi(a.z) * bfhi(w.z)); o.w = cvt_pk_bf16(bflo(a.w) * bflo(w.w), bfhi(a.w) * bfhi(w.w));
            *(v4u*)(up + (size_t)k * 16 * 4096) = o; }
        __syncthreads();
    }
#undef SG_LOAD_VR
}

__device__ __forceinline__ void convert_even(const float* w_in, const float* w_qb, const float* w_kvb, const float* w_out, const float* qg, bf16* WEIN, bf16* WEQB, bf16* WEKVB, bf16* WEOUT, LAS float* scr, int w, int nw, int lane) {
    constexpr int I_IN = 32 * (EVEN_IN / 32), I_QB = 8 * 96, I_KVB = 8 * 128, I_OUT = 64 * 64;
    for (int it = w; it < I_IN + I_QB + I_KVB + I_OUT; it += nw) { int r = it;
        if (r < I_IN) { cvt_item(w_in, 2048, EVEN_IN, WEIN, DestEvenIn{}, (const float*)nullptr, scr, r, lane); continue; } r -= I_IN;
        if (r < I_QB) { cvt_item(w_qb, 512, 3072, WEQB, DestQb{}, qg, scr, r, lane); continue; } r -= I_QB;
        if (r < I_KVB) { cvt_item(w_kvb, 512, 4096, WEKVB, DestP32{}, (const float*)nullptr, scr, r, lane); continue; } r -= I_KVB;
        cvt_item(w_out, 4096, 2048, WEOUT, DestP32{}, (const float*)nullptr, scr, r, lane); }
    for (int q = w * 64 + lane; q < 192 * 2048 / 8; q += nw * 64) *(v4u*)(WEIN + (size_t)9280 * 2048 + (size_t)q * 8) = zero4();
}
__device__ __forceinline__ void convert_odd(const float* w_in, const float* w_out, const float* wsrc, bf16* WOIN, bf16* WOOUT, bf16* WOS, LAS float* scr, int w, int nw, int lane) {
    constexpr int I_IN = 32 * (ODD_IN / 32), I_OUT = 64 * 64;
    for (int it = w; it < I_IN + I_OUT; it += nw) { int r = it;
        if (r < I_IN) { cvt_item(w_in, 2048, ODD_IN, WOIN, DestOddIn{}, (const float*)nullptr, scr, r, lane); continue; } r -= I_IN;
        cvt_item(w_out, 4096, 2048, WOOUT, DestP32{}, (const float*)nullptr, scr, r, lane); }
    for (int q = w * 64 + lane; q < 16 * 128 * 128 / 8; q += nw * 64) *(v4u*)(WOS + (size_t)q * 8) = pack8(*(const f32x4*)(wsrc + (size_t)q * 8), *(const f32x4*)(wsrc + (size_t)q * 8 + 4));
}

constexpr int NPH = 26;
#ifndef MK_N_LAUNCHES
#define MK_N_LAUNCHES 1
#endif
struct Args { const float* in[23]; float* out; unsigned char* ws; int ph_lo, ph_hi; };
__global__ void __launch_bounds__(512, 2) fwd(Args args) {
    extern __shared__ __attribute__((aligned(16))) unsigned char lds_raw[];
    LAS unsigned char* lds = (LAS unsigned char*)lds_raw;
    volatile LAS unsigned* MISC = (volatile LAS unsigned*)(lds + MISC_OFF);
    const int tid0 = threadIdx.x, lane0 = tid0 & 63, wave = __builtin_amdgcn_readfirstlane(tid0 >> 6);
    const int G0 = gridDim.x, bx0 = blockIdx.x, vcu0 = (G0 % 8 == 0) ? (bx0 % 8) * (G0 / 8) + bx0 / 8 : bx0;
    for (int u = tid0; u < (LDS_BYTES - LDSCTL_OFF) / 4; u += 512) ((LAS unsigned*)(lds + LDSCTL_OFF))[u] = 0u;
    __syncthreads();
    XcdBarrier bar = xcd_barrier_post((unsigned*)(args.ws + WS_CTL) + CW_BAR, MISC + 8);
    const int lo = args.ph_lo, hi = args.ph_hi; (void)lo; (void)hi;
#ifndef PH_MASK
#define PH_MASK 0xFFFF
#endif
#define EN(b) (((PH_MASK) >> (b)) & 1)
#ifndef PROBE_DUP
#define PROBE_DUP 0
#endif
#define REPS(b) for (int rep_ = 0; rep_ < ((((PROBE_DUP) >> (b)) & 1) ? 2 : 1); ++rep_)
#if MK_N_LAUNCHES == 1
#define IN(k) true
#else
#define IN(k) (lo <= (k) && (k) < hi)
#endif
#define SEAM(k) do { if (IN((k) + 1)) { XcdBarrier b_ = bar; asm volatile("" : "+s"(b_.bar), "+s"(b_.x)); xcd_barrier(b_); } } while (0)
#define PHASE_Z() int z_ = 0; asm volatile("; phase" : "+s"(z_)); unsigned char* ws = args.ws + z_; int lane = lane0; asm volatile("" : "+v"(lane)); const int tid = wave * 64 + lane; \
    int G = G0, bx = bx0, vcu = vcu0; asm volatile("" : "+s"(G), "+s"(bx), "+s"(vcu)); const int gw = vcu * 8 + wave, ngw = G * 8; (void)tid; (void)gw; (void)ngw; (void)bx
#define INP(k) (args.in[(k) + z_])
#define XO ((float*)args.out + z_)
#define NEW_CKV (XO + (size_t)MT * DM)
#define NEW_KPE (NEW_CKV + (size_t)16 * 2 * 256 * 512)
#define MOD ((float*)(ws + WS_MOD))
#define ROPE ((float*)(ws + WS_ROPE))
#define WSP(off) ((bf16*)(ws + (off)))
#define CONVERT_EVEN(ii, w_, nw_) convert_even(INP(9) + (size_t)(ii) * 2048 * EVEN_IN, INP(12) + (size_t)(ii) * 512 * 3072, INP(14) + (size_t)(ii) * 512 * 4096, INP(15) + (size_t)(ii) * 4096 * 2048, INP(11) + (ii) * 512, \
        WSP(WE_IN), WSP(WE_QB), WSP(WE_KVB), WSP(WE_OUT), scr, (w_), (nw_), lane)
#define CONVERT_ODD(ii, w_, nw_) convert_odd(INP(16) + (size_t)(ii) * 2048 * ODD_IN, INP(21) + (size_t)(ii) * 4096 * 2048, INP(19) + (size_t)(ii) * 16 * 128 * 128, WSP(WO_IN), WSP(WO_OUT), WSP(WO_S), scr, (w_), (nw_), lane)
#define TAIL_WORKERS() const int R_ = 1152 % G, cw_ = R_ ? bx - R_ : bx, ncw_ = R_ ? G - R_ : G
    LAS float* scr = (LAS float*)(lds + wave * 16384);

    if (EN(0) && IN(0)) { PHASE_Z();
        for (int it = bx; it < 96; it += G) adaln_item(lds, INP(4), INP(5), INP(7), INP(8), MOD, it, tid);
        { const int cw_ = G > 96 ? bx - 96 : bx, ncw_ = G > 96 ? G - 96 : G; if (cw_ >= 0) CONVERT_EVEN(0, cw_ * 8 + wave, ncw_ * 8); }
        if (bx == G - 1 && tid < 16) { const double ct = ROPE_CT[tid], st = ROPE_ST[tid]; double cc = 1.0, ss = 0.0; float* rope = ROPE;
            for (int pos = 0; pos < 64; ++pos) { rope[(pos * 16 + tid) * 2] = (float)cc; rope[(pos * 16 + tid) * 2 + 1] = (float)ss; const double nc = cc * ct - ss * st; ss = ss * ct + cc * st; cc = nc; } }
        SEAM(0);
    }
    for (int lp = 0; lp < 2; ++lp) {
        const int pb = 1 + 12 * lp, i = lp;
        { const int l = 2 * lp;
        if (EN(1) && IN(pb + 0)) { PHASE_Z();
            REPS(1) {
            if (l == 0) modnorm_rows(INP(0), INP(1), XO, 1, INP(6) + (size_t)l * DM, MOD + (size_t)l * 9 * 6144, WSP(WS_HE), gw, ngw, lane);
            else modnorm_rows_bf(WSP(WS_XB), INP(6) + (size_t)l * DM, MOD + (size_t)l * 9 * 6144, WSP(WS_HE), gw, ngw, lane);
            }
            SEAM(pb + 0);
        }
        if (EN(2) && IN(pb + 1)) { PHASE_Z();
            REPS(2) {
            pg8::Gemm g{WSP(WS_HE), WSP(WE_IN), MT, EVEN_NV, 2048}; pg8::StaticOrder S; S.init(MT, EVEN_NV, G, bx);
            pg8::EpiEvenIn E{WSP(WS_MIX), WSP(WS_PPB), WSP(WS_U1B), WSP(WS_QA), WSP(WS_CKVR), WSP(WS_KPE), NEW_KPE + (size_t)i * 256 * 64, ROPE, INP(10) + (size_t)i * 3 * 2048};
            pg8::gemm_phase<pg8::EpiEvenIn, pg8::StaticOrder, true, true>(lds, g, S, E);
            }
            if (G == 256) { const int R_ = ((MT / 256) * (EVEN_NV / 256)) % G, cw_ = R_ ? bx - R_ : -1, ncw_ = G - R_; if (cw_ >= 0) CONVERT_ODD(i, cw_ * 8 + wave, ncw_ * 8); }
            SEAM(pb + 1);
        }
        if (EN(3) && IN(pb + 2)) { PHASE_Z();
            REPS(3) {
            e3_norm_rows(WSP(WS_QA), WSP(WS_CKVR), INP(13) + i * 512, WSP(WS_QN), WSP(WS_CKV), NEW_CKV + (size_t)i * 256 * 512, gw, ngw, lane);
            e3_cache_rows(INP(2) + (size_t)i * 512 * 512, INP(3) + (size_t)i * 512 * 64, WSP(WS_CKV), WSP(WS_KPE), gw, ngw, lane);
            e3_conv_fix(WSP(WS_U1B), WSP(WS_PPB), INP(10) + (size_t)i * 3 * 2048, WSP(WS_MIX), gw, ngw, lane);
            }
            SEAM(pb + 2);
        }
        for (int hg = 0; hg < 2; ++hg) {
            if (EN(4) && IN(pb + 3 + 2 * hg)) { PHASE_Z();
            REPS(4) {
                { pg8::Gemm g{WSP(WS_QN), WSP(WE_QB) + (size_t)hg * 1536 * 512, MT, 1536, 512}; pg8::StaticOrder S; S.init(MT, 1536, G, bx); pg8::EpiQ E{WSP(WS_Q), ROPE};
                  pg8::gemm_phase<pg8::EpiQ, pg8::StaticOrder, true, true>(lds, g, S, E); }
                { pg8::Gemm g{WSP(WS_CKV), WSP(WE_KVB) + (size_t)hg * 2048 * 512, KVR, 2048, 512}; pg8::StaticOrder S; S.init(KVR, 2048, G, bx); pg8::EpiStore E{WSP(WS_KV), 2048};
                  pg8::gemm_phase<pg8::EpiStore, pg8::StaticOrder, true, true>(lds, g, S, E); }
            }
                SEAM(pb + 3 + 2 * hg);
            }
            if (EN(5) && IN(pb + 4 + 2 * hg)) { PHASE_Z();
            REPS(5) {
                const bf16* Qb = WSP(WS_Q); const unsigned char* KVb = ws + WS_KV; const unsigned char* KPEb = ws + WS_KPE; bf16* MIX = WSP(WS_MIX);
                for (int u = vcu; u < 1152; u += G) {
                    int b, hl, qrow0, kvrow0, NT;
                    if (u < 1024) { b = u >> 7; hl = (u >> 4) & 7; qrow0 = NPR + b * 4096 + (u & 15) * 256; kvrow0 = NPR + b * KVS; NT = 72; }
                    else { const int v = u - 1024; b = v >> 3; hl = v & 7; qrow0 = b * 256; kvrow0 = b * 256; NT = 4; }
                    const int h = hg * 8 + hl; const unsigned char* kvp = KVb + ((size_t)kvrow0 * 2048 + hl * 256) * 2;
                    att::unit(lds, Qb + (size_t)qrow0 * 1536 + hl * 192, 1536, kvp, kvp + 256, KPEb + (size_t)kvrow0 * 128, NT,
                              MIX + (size_t)qrow0 * 4096 + 2048 + h * 128, 4096, MIX + (size_t)qrow0 * 4096 + 2048 + h * 128, 4096);
                }
            }
                SEAM(pb + 4 + 2 * hg);
            }
        }
        if (EN(6) && IN(pb + 7)) { PHASE_Z();
            pg8::Gemm g{WSP(WS_MIX), WSP(WE_OUT), MT, 2048, 4096}; pg8::TailSplitOrder S; S.init(MT, 2048, G, bx, true);
            pg8::EpiResid E{INP(0), INP(1), WSP(WS_XB), XO, MOD + (size_t)l * 9 * 6144 + 4096, l == 0 ? 1 : 0, 0, WSP(WS_PEND_E)};
            pg8::gemm_phase<pg8::EpiResid, pg8::TailSplitOrder, true, true, true>(lds, g, S, E);
            if (!S.split) { TAIL_WORKERS(); if (cw_ >= 0) CONVERT_ODD(i, cw_ * 8 + wave, ncw_ * 8); }
            SEAM(pb + 7);
        }
        }
        { const int l = 2 * lp + 1;
        if (EN(7) && IN(pb + 8)) { PHASE_Z();
            REPS(7) {
            modnorm_rows_bf(WSP(WS_XB), INP(6) + (size_t)l * DM, MOD + (size_t)l * 9 * 6144, WSP(WS_HO), gw, ngw, lane, G == 256 ? WSP(WS_PEND_E) : nullptr);
            }
            SEAM(pb + 8);
        }
        if (EN(8) && IN(pb + 9)) { PHASE_Z();
            REPS(8) {
            pg8::Gemm g{WSP(WS_HO), WSP(WO_IN), MT, ODD_IN, 2048}; pg8::StaticOrder S; S.init(MT, ODD_IN, G, bx);
            pg8::EpiOddIn E{WSP(WS_UG), WSP(WS_VR), (float*)(ws + WS_STATS)};
            pg8::gemm_phase<pg8::EpiOddIn, pg8::StaticOrder, true, true>(lds, g, S, E);
            }
            SEAM(pb + 9);
        }
        if (EN(9) && IN(pb + 10)) { PHASE_Z();
            sg_phase(lds, vcu, G, WSP(WS_VR), (const float*)(ws + WS_STATS), INP(17) + (size_t)i * 4096, INP(18) + (size_t)i * 4096, WSP(WO_S), INP(20) + (size_t)i * 16 * 128, WSP(WS_UG));
            SEAM(pb + 10);
        }
        if (EN(10) && IN(pb + 11)) { PHASE_Z();
            pg8::Gemm g{WSP(WS_UG), WSP(WO_OUT), MT, 2048, 4096}; pg8::TailSplitOrder S; S.init(MT, 2048, G, bx, lp + 1 == 2);
            pg8::EpiResid E{INP(0), INP(1), WSP(WS_XB), XO, MOD + (size_t)l * 9 * 6144 + 4096, 0, 0, WSP(WS_PEND_O)};
            pg8::gemm_phase<pg8::EpiResid, pg8::TailSplitOrder, true, true, true>(lds, g, S, E);
            if (lp + 1 < 2) { TAIL_WORKERS(); if (cw_ >= 0) CONVERT_EVEN(i + 1, cw_ * 8 + wave, ncw_ * 8); }
            SEAM(pb + 11);
        }
        }
    }
    if (EN(11) && IN(25)) { PHASE_Z(); final_rows(WSP(WS_XB), XO, INP(22), gw, ngw, lane, G == 256 ? WSP(WS_PEND_O) : nullptr); }
#undef IN
#undef SEAM
}

extern "C" void kernel_launch(void* const* d_in, const int* in_sizes, int n_in, void* d_out, int out_size, void* d_ws, size_t ws_size, hipStream_t stream) {
    static int grid = 0;
    if (grid == 0) {
        if (n_in != 23 || in_sizes[0] != NPR * DM || in_sizes[1] != NSM * DM || out_size != MT * DM + 16 * 2 * 256 * 512 + 16 * 2 * 256 * 64 || ws_size < WS_END) {
            fprintf(stderr, "kernel_launch: shape mismatch (n_in %d, out %d, ws %zu, need %zu); nothing launched\n", n_in, out_size, ws_size, (size_t)WS_END); grid = -1; return; }
        int dev = 0, cus = 0, per_cu = 0;
        if (hipGetDevice(&dev) != hipSuccess || hipDeviceGetAttribute(&cus, hipDeviceAttributeMultiprocessorCount, dev) != hipSuccess) { grid = -1; return; }
        if (hipFuncSetAttribute((const void*)fwd, hipFuncAttributeMaxDynamicSharedMemorySize, LDS_BYTES) != hipSuccess) { fprintf(stderr, "kernel_launch: hipFuncSetAttribute failed\n"); grid = -1; return; }
        if (hipOccupancyMaxActiveBlocksPerMultiprocessor(&per_cu, (const void*)fwd, 512, LDS_BYTES) != hipSuccess || per_cu < 1) fprintf(stderr, "kernel_launch: occupancy query reports %d\n", per_cu);
        (void)hipGetLastError();
        grid = cus;
    }
    if (grid < 0) return;
    if (hipMemsetAsync((char*)d_ws + WS_CTL, 0, CTL_ZERO_BYTES, stream) != hipSuccess) return;
    Args a{};
    for (int i = 0; i < 23; ++i) a.in[i] = (const float*)d_in[i];
    a.out = (float*)d_out; a.ws = (unsigned char*)d_ws;
#if MK_N_LAUNCHES == 1
    a.ph_lo = 0; a.ph_hi = NPH;
    hipLaunchKernelGGL(fwd, dim3(grid), dim3(512), LDS_BYTES, stream, a);
#else
    for (int k = 0; k < NPH; ++k) { a.ph_lo = k; a.ph_hi = k + 1; hipLaunchKernelGGL(fwd, dim3(grid), dim3(512), LDS_BYTES, stream, a); }
#endif
    const hipError_t le = hipPeekAtLastError();
    if (le != hipSuccess) fprintf(stderr, "kernel_launch: launch failed: %s\n", hipGetErrorName(le));
}
```
